# Optimizing an MI355X kernel written in HIP

```python
import jax, jax.numpy as jnp
from jax import lax
import numpy as np

D_MODEL = 1024
BATCH = 32
SEQ = 256
DEPTH = 4
DEC_BATCH = 4
DEC_SEQ = 2048
PAST_LEN = 512

GRID_W = 64
N_MIXERS = 2
N_A_LAYERS = (DEPTH + 1) // 2
N_B_LAYERS = DEPTH // 2
A_HEADS = 8
A_DK = D_MODEL // A_HEADS
A_DV = D_MODEL // A_HEADS
A_FDIM = A_HEADS * A_DK
A_VDIM = A_HEADS * A_DV
A_IN = 3 * A_FDIM + 2 * A_VDIM
CHUNK = 32
ATT_HEADS = 8
KV_HEADS = 2
GROUP = ATT_HEADS // KV_HEADS
HEAD_DIM = D_MODEL // ATT_HEADS
QKV_DIM = (ATT_HEADS + 2 * KV_HEADS) * HEAD_DIM
WINDOW = 128
BLOCK = 128
D_FF = ((8 * D_MODEL // 3 + 255) // 256) * 256
ROPE_BASE = 10000.0
EPS = 1e-6
F32 = jnp.float32

kernel_name = 'hybrid_hgrn2_swa_diffusion_step'


def rmsnorm(x, g):
    xf = x.astype(F32)
    y = xf * lax.rsqrt(jnp.mean(xf * xf, axis=-1, keepdims=True) + EPS)
    return (y * g.astype(F32)).astype(x.dtype)


def modulate(h, shift, scale):
    return h * (1 + scale) + shift


def adaln(cond, w, b):
    mod = jax.nn.silu(cond) @ w + b
    return jnp.split(mod[:, None, :], 6, axis=-1)


def swiglu(h, w_gu, w_d):
    g, u = jnp.split(h @ w_gu, 2, axis=-1)
    return (jax.nn.silu(g) * u) @ w_d


def rope_1d(x, pos):
    half = x.shape[-1] // 2
    inv = ROPE_BASE ** (-jnp.arange(half, dtype=F32) / half)
    ang = pos[:, None] * inv[None, :]
    cos = jnp.cos(ang)[None, :, None, :]
    sin = jnp.sin(ang)[None, :, None, :]
    xf = x.astype(F32)
    x1, x2 = xf[..., :half], xf[..., half:]
    return jnp.concatenate([x1 * cos - x2 * sin, x1 * sin + x2 * cos], axis=-1).astype(x.dtype)


def axial_rope(x, row_pos, col_pos):
    h = x.shape[-1] // 2
    return jnp.concatenate([rope_1d(x[..., :h], row_pos), rope_1d(x[..., h:], col_pos)], axis=-1)


def grid_positions(n):
    rows = n // GRID_W
    row_pos = jnp.repeat(jnp.arange(rows, dtype=F32), GRID_W)
    col_pos = jnp.tile(jnp.arange(GRID_W, dtype=F32), rows)
    return row_pos, col_pos


def hgrn_lower_bounds(lb_param):
    p = jax.nn.softmax(lb_param.astype(F32), axis=0)
    cs = jnp.cumsum(p, axis=0)
    return cs - cs[:1]


def gla_scan(q, k, v, logf, s0):
    B, N, H, _ = q.shape
    nc = N // CHUNK

    def to_chunks(a):
        return a.reshape(B, nc, CHUNK, H, a.shape[-1]).transpose(1, 0, 3, 2, 4)

    causal = jnp.tril(jnp.ones((CHUNK, CHUNK), dtype=bool))[:, :, None]

    def step(S, inp):
        qc, kc, vc, gc = inp
        b = jnp.cumsum(gc, axis=2)
        o_inter = jnp.einsum('bhtd,bhde->bhte', qc * jnp.exp(b), S)
        rel = b[:, :, :, None, :] - b[:, :, None, :, :]
        decay = jnp.exp(jnp.where(causal, rel, -jnp.inf))
        scores = jnp.einsum('bhtd,bhsd,bhtsd->bhts', qc, kc, decay)
        o_intra = jnp.einsum('bhts,bhse->bhte', scores, vc)
        b_last = b[:, :, -1]
        k_dec = kc * jnp.exp(b_last[:, :, None, :] - b)
        S_new = jnp.exp(b_last)[..., None] * S + jnp.einsum('bhsd,bhse->bhde', k_dec, vc)
        return S_new, o_inter + o_intra

    s_fin, o = lax.scan(step, s0, (to_chunks(q), to_chunks(k), to_chunks(v), to_chunks(logf)))
    o = o.transpose(1, 0, 3, 2, 4).reshape(B, N, H, v.shape[-1])
    return o, s_fin


def hgrn_mixer(h, w_in, gnorm, w_out, lb, s0):
    B, N, _ = h.shape
    proj = h @ w_in
    q, zf, zb, iv, g = jnp.split(proj, [A_FDIM, 2 * A_FDIM, 3 * A_FDIM, 3 * A_FDIM + A_VDIM], axis=-1)

    def heads(a, d):
        return a.reshape(B, N, A_HEADS, d)

    def gate(z, lbd):
        f = lbd + (1 - lbd) * jax.nn.sigmoid(z.astype(F32))
        return 1 - f, jnp.log(f)

    qf = jax.nn.silu(heads(q, A_DK).astype(F32))
    v = heads(iv, A_DV).astype(F32)
    k_fw, g_fw = gate(heads(zf, A_DK), lb[0].reshape(A_HEADS, A_DK))
    k_bw, g_bw = gate(heads(zb, A_DK), lb[1].reshape(A_HEADS, A_DK))
    s0f = s0.astype(F32)

    def rev(a):
        return jnp.flip(a, axis=1)

    o_fw, s_fw = gla_scan(qf, k_fw, v, g_fw, s0f[:, 0])
    o_bw, s_bw = gla_scan(rev(qf), rev(k_bw), rev(v), rev(g_bw), s0f[:, 1])
    o = o_fw + rev(o_bw)
    o = o * lax.rsqrt(jnp.mean(o * o, axis=-1, keepdims=True) + EPS) * gnorm.reshape(A_HEADS, A_DV).astype(F32)
    o = o.astype(h.dtype) * jax.nn.silu(heads(g, A_DV))
    out = o.reshape(B, N, A_VDIM) @ w_out
    return out, jnp.stack([s_fw, s_bw], axis=1).astype(s0.dtype)


def qkv_heads(h, w_qkv):
    B, N, _ = h.shape
    proj = h @ w_qkv
    q = proj[..., :ATT_HEADS * HEAD_DIM].reshape(B, N, ATT_HEADS, HEAD_DIM)
    k = proj[..., ATT_HEADS * HEAD_DIM:(ATT_HEADS + KV_HEADS) * HEAD_DIM].reshape(B, N, KV_HEADS, HEAD_DIM)
    v = proj[..., (ATT_HEADS + KV_HEADS) * HEAD_DIM:].reshape(B, N, KV_HEADS, HEAD_DIM)
    return q, k, v


def sink_logits(sink, shape):
    s = sink.reshape(KV_HEADS, GROUP).astype(F32)[:, :, None, None]
    return jnp.broadcast_to(s, shape[:-1] + (1,))


def attn_context(h, w_qkv, w_o, sink):
    B, S, _ = h.shape
    q, k, v = qkv_heads(h, w_qkv)
    nq = S // BLOCK
    qb = q.reshape(B, nq, BLOCK, KV_HEADS, GROUP, HEAD_DIM).transpose(1, 0, 2, 3, 4, 5)
    scale = HEAD_DIM ** -0.5

    def one_block(qi):
        lg = jnp.einsum('bqkgd,bskd->bkgqs', qi, k).astype(F32) * scale
        p = jax.nn.softmax(jnp.concatenate([sink_logits(sink, lg.shape), lg], axis=-1), axis=-1)
        return jnp.einsum('bkgqs,bskd->bqkgd', p[..., 1:].astype(h.dtype), v)

    o = lax.map(one_block, qb)
    o = o.transpose(1, 0, 2, 3, 4, 5).reshape(B, S, ATT_HEADS * HEAD_DIM)
    return o @ w_o, k, v


def attn_latent(h, w_qkv, w_o, sink, k_ctx, v_ctx, row_pos, col_pos):
    B, N, _ = h.shape
    q, k, v = qkv_heads(h, w_qkv)
    q = axial_rope(q, row_pos, col_pos)
    k = axial_rope(k, row_pos, col_pos)
    nb = N // BLOCK
    qb = q.reshape(B, nb, BLOCK, KV_HEADS, GROUP, HEAD_DIM)

    def band(a):
        ap = jnp.pad(a, ((0, 0), (BLOCK, BLOCK), (0, 0), (0, 0))).reshape(B, nb + 2, BLOCK, KV_HEADS, HEAD_DIM)
        return jnp.concatenate([ap[:, :-2], ap[:, 1:-1], ap[:, 2:]], axis=2)

    kb, vb = band(k), band(v)
    qi = jnp.arange(BLOCK)[:, None]
    kj = jnp.arange(3 * BLOCK)[None, :]
    rel = kj - BLOCK - qi
    key_pos = (jnp.arange(nb)[:, None, None] - 1) * BLOCK + kj[None]
    mask = (jnp.abs(rel)[None] <= WINDOW) & (key_pos >= 0) & (key_pos < N)
    scale = HEAD_DIM ** -0.5
    lw = jnp.einsum('bnqkgd,bnskd->bnkgqs', qb, kb).astype(F32) * scale
    lw = jnp.where(mask[None, :, None, None], lw, -jnp.inf)
    lc = jnp.einsum('bnqkgd,bpkd->bnkgqp', qb, k_ctx).astype(F32) * scale
    p = jax.nn.softmax(jnp.concatenate([sink_logits(sink, lw.shape), lc, lw], axis=-1), axis=-1)
    P = k_ctx.shape[1]
    pc = p[..., 1:1 + P].astype(h.dtype)
    pw = p[..., 1 + P:].astype(h.dtype)
    o = jnp.einsum('bnkgqp,bpkd->bnqkgd', pc, v_ctx) + jnp.einsum('bnkgqs,bnskd->bnqkgd', pw, vb)
    return o.reshape(B, N, ATT_HEADS * HEAD_DIM) @ w_o


def setup_inputs(seed: int = 0) -> dict:
    key = jax.random.key(seed)
    ks = jax.random.split(key, 21)

    def nrm(k, shape, scale):
        return jax.random.normal(k, shape, F32) * scale

    return {
        'x_prompt': nrm(ks[0], (BATCH, SEQ, D_MODEL), 1.0),
        'x_sample': nrm(ks[1], (DEC_BATCH, DEC_SEQ, D_MODEL), 1.0),
        'cache_k': nrm(ks[2], (DEC_BATCH, N_B_LAYERS, PAST_LEN, KV_HEADS, HEAD_DIM), 1.0),
        'cache_v': nrm(ks[3], (DEC_BATCH, N_B_LAYERS, PAST_LEN, KV_HEADS, HEAD_DIM), 1.0),
        'state_hgrn': nrm(ks[4], (DEC_BATCH, N_A_LAYERS, 2, A_HEADS, A_DK, A_DV), 0.5),
        'c': nrm(ks[5], (DEC_BATCH, D_MODEL), 1.0),
        'c_ctx': nrm(ks[6], (D_MODEL,), 1.0),
        'w_ada': nrm(ks[7], (DEPTH, D_MODEL, 6 * D_MODEL), 0.5 * D_MODEL ** -0.5),
        'b_ada': nrm(ks[8], (DEPTH, 6 * D_MODEL), 0.01),
        'norm1': 1.0 + nrm(ks[9], (DEPTH, D_MODEL), 0.01),
        'norm2': 1.0 + nrm(ks[10], (DEPTH, D_MODEL), 0.01),
        'norm_final': 1.0 + nrm(ks[11], (D_MODEL,), 0.01),
        'w_gate_up': nrm(ks[12], (DEPTH, D_MODEL, 2 * D_FF), D_MODEL ** -0.5),
        'w_down': nrm(ks[13], (DEPTH, D_FF, D_MODEL), D_FF ** -0.5),
        'w_in_a': nrm(ks[14], (N_A_LAYERS, D_MODEL, A_IN), D_MODEL ** -0.5),
        'lower_bounds': nrm(ks[15], (N_A_LAYERS, 2, A_FDIM), 1.0),
        'gnorm_a': 1.0 + nrm(ks[16], (N_A_LAYERS, A_VDIM), 0.01),
        'w_out_a': nrm(ks[17], (N_A_LAYERS, A_VDIM, D_MODEL), A_VDIM ** -0.5),
        'w_qkv_b': nrm(ks[18], (N_B_LAYERS, D_MODEL, QKV_DIM), D_MODEL ** -0.5),
        'w_out_b': nrm(ks[19], (N_B_LAYERS, ATT_HEADS * HEAD_DIM, D_MODEL), (ATT_HEADS * HEAD_DIM) ** -0.5),
        'sink_b': nrm(ks[20], (N_B_LAYERS, ATT_HEADS), 1.0),
    }


def reference(x_prompt, x_sample, cache_k, cache_v, state_hgrn, c, c_ctx, w_ada, b_ada, norm1, norm2, norm_final,
              w_gate_up, w_down, w_in_a, lower_bounds, gnorm_a, w_out_a, w_qkv_b, w_out_b, sink_b):
    lb_all = hgrn_lower_bounds(lower_bounds)

    x = x_prompt
    cond_ctx = c_ctx[None, :]
    new_k, new_v, new_s = [], [], []
    for l in range(DEPTH):
        sh1, sc1, g1, sh2, sc2, g2 = adaln(cond_ctx, w_ada[l], b_ada[l])
        h = modulate(rmsnorm(x, norm1[l]), sh1, sc1)
        j = l // N_MIXERS
        if l % N_MIXERS == 0:
            s0 = jnp.zeros((x.shape[0], 2, A_HEADS, A_DK, A_DV), x.dtype)
            out, s_fin = hgrn_mixer(h, w_in_a[j], gnorm_a[j], w_out_a[j], lb_all[j], s0)
            new_s.append(s_fin)
        else:
            out, k_c, v_c = attn_context(h, w_qkv_b[j], w_out_b[j], sink_b[j])
            new_k.append(k_c)
            new_v.append(v_c)
        x = x + g1 * out
        x = x + g2 * swiglu(modulate(rmsnorm(x, norm2[l]), sh2, sc2), w_gate_up[l], w_down[l])
    y_prompt = rmsnorm(x, norm_final)
    new_cache_k = jnp.stack(new_k, axis=1)
    new_cache_v = jnp.stack(new_v, axis=1)
    new_state_hgrn = jnp.stack(new_s, axis=1)

    x = x_sample
    row_pos, col_pos = grid_positions(x_sample.shape[1])
    for l in range(DEPTH):
        sh1, sc1, g1, sh2, sc2, g2 = adaln(c, w_ada[l], b_ada[l])
        h = modulate(rmsnorm(x, norm1[l]), sh1, sc1)
        j = l // N_MIXERS
        if l % N_MIXERS == 0:
            out, _ = hgrn_mixer(h, w_in_a[j], gnorm_a[j], w_out_a[j], lb_all[j], state_hgrn[:, j])
        else:
            out = attn_latent(h, w_qkv_b[j], w_out_b[j], sink_b[j], cache_k[:, j], cache_v[:, j], row_pos, col_pos)
        x = x + g1 * out
        x = x + g2 * swiglu(modulate(rmsnorm(x, norm2[l]), sh2, sc2), w_gate_up[l], w_down[l])
    y_sample = rmsnorm(x, norm_final)

    return (y_prompt, y_sample, new_cache_k, new_cache_v, new_state_hgrn)
```

```cpp
#include <hip/hip_runtime.h>
#include <hip/hip_cooperative_groups.h>
#include <cstdio>
#include <cstdint>
namespace cg = cooperative_groups;

#define LAS __attribute__((address_space(3)))
typedef unsigned short bf16_t;
typedef short bf16x8 __attribute__((ext_vector_type(8)));
typedef short s16x4 __attribute__((ext_vector_type(4)));
typedef float f32x4 __attribute__((ext_vector_type(4)));
typedef float f32x2 __attribute__((ext_vector_type(2)));
typedef float f32x16 __attribute__((ext_vector_type(16)));
typedef unsigned u32x4 __attribute__((ext_vector_type(4)));
typedef unsigned u32x2 __attribute__((ext_vector_type(2)));
typedef __bf16 bf16x2_t __attribute__((ext_vector_type(2)));
typedef _Float16 f16x2_t __attribute__((ext_vector_type(2)));
typedef LAS unsigned char* lptr;
typedef const float* cfp_t; typedef __attribute__((address_space(4))) const cfp_t* inptr_t;

constexpr int DM = 1024, M_CTX = 8192, M_TOT = 16384, NCOND = 5, DEPTH = 4;
constexpr int A_IN = 5120, QKV_N = 1536, D_FF = 2816, GU_N = 5632;
constexpr float EPS = 1e-6f;
constexpr float LOG2E = 1.4426950408889634f;
constexpr int NTHREADS = 512, NWAVES = 8;

constexpr size_t OUT_Y = 0, OUT_CK = 16777216, OUT_CV = 20971520, OUT_ST = 25165824, OUT_TOTAL = 41943040;

constexpr size_t MiB = 1u << 20;
constexpr size_t WS_CTL = 0;
constexpr size_t WS_MOD = 1 * MiB;
constexpr size_t WS_SS = WS_MOD + 512 * 1024;
constexpr size_t WS_ZERO_BYTES = 2 * MiB + 256 * 1024;
constexpr size_t WS_BIAS_IN = 3 * MiB;
constexpr size_t WS_BIAS_QKV = WS_BIAS_IN + 2 * 5 * 5120 * 4;
constexpr size_t WS_BIAS_GU = WS_BIAS_QKV + 2 * 5 * 1536 * 4;
constexpr size_t WS_LB = WS_BIAS_GU + 4 * 5 * 5632 * 4;
constexpr size_t WS_ROPE = WS_LB + 4 * 1024 * 4;
constexpr size_t WS_TAB_END = WS_ROPE + 2 * 2 * 64 * 32 * 4;
static_assert(WS_TAB_END <= 4 * MiB, "tables");
constexpr size_t WS_W_IN = 4 * MiB;
constexpr size_t WS_W_OUTA = WS_W_IN + (size_t)2 * 5120 * 1024 * 2;
constexpr size_t WS_W_QKV = WS_W_OUTA + (size_t)2 * 1024 * 1024 * 2;
constexpr size_t WS_W_OUTB = WS_W_QKV + (size_t)2 * 1536 * 1024 * 2;
constexpr size_t WS_W_GU = WS_W_OUTB + (size_t)2 * 1024 * 1024 * 2;
constexpr size_t WS_W_DN = WS_W_GU + (size_t)4 * 5632 * 1024 * 2;
constexpr size_t WS_CK = WS_W_DN + (size_t)4 * 1024 * 2816 * 2;
constexpr size_t WS_CVT = WS_CK + (size_t)4 * 2 * 512 * 256 * 2;
constexpr size_t WS_XA = WS_CVT + (size_t)4 * 2 * 512 * 256 * 2;
constexpr size_t WS_A2 = WS_XA + (size_t)M_TOT * DM * 2;
constexpr size_t WS_R = WS_A2 + (size_t)M_TOT * DM * 2;
constexpr size_t ACT = (size_t)M_TOT * DM * 2;
constexpr size_t WS_HQ = WS_R, WS_HKF = WS_R + ACT, WS_HKB = WS_R + 2 * ACT, WS_HV = WS_R + 3 * ACT, WS_HGF = WS_R + 4 * ACT, WS_HGB = WS_R + 5 * ACT;
constexpr size_t WS_H = WS_R;
constexpr size_t WS_AQ = WS_R, WS_AK = WS_R + ACT, WS_AVT = WS_AK + (size_t)M_TOT * 256 * 2;
constexpr size_t WS_END = WS_R + 6 * ACT;

__device__ __forceinline__ unsigned pk_bf16(float lo, float hi) { f32x2 v = {lo, hi}; bf16x2_t b = __builtin_convertvector(v, bf16x2_t); return __builtin_bit_cast(unsigned, b); }
__device__ __forceinline__ bf16_t to_bf16(float x) { return (bf16_t)(pk_bf16(x, 0.f) & 0xffffu); }
__device__ __forceinline__ float bf_lo(unsigned u) { return __uint_as_float(u << 16); }
__device__ __forceinline__ float bf_hi(unsigned u) { return __uint_as_float(u & 0xffff0000u); }
__device__ __forceinline__ unsigned pk_f16(float lo, float hi) { f32x2 v = {lo, hi}; f16x2_t h = __builtin_convertvector(v, f16x2_t); return __builtin_bit_cast(unsigned, h); }
__device__ __forceinline__ f32x2 unpk_f16(unsigned u) { f16x2_t h = __builtin_bit_cast(f16x2_t, u); return __builtin_convertvector(h, f32x2); }
__device__ __forceinline__ float fast_exp2(float x) { return __builtin_amdgcn_exp2f(x); }
__device__ __forceinline__ float fast_rcp(float x) { return __builtin_amdgcn_rcpf(x); }
__device__ __forceinline__ float silu_f(float z) { z = fminf(fmaxf(z, -60.f), 60.f); return z * fast_rcp(1.f + fast_exp2(-z * LOG2E)); }
__device__ __forceinline__ float wave_sum(float v) {
#pragma unroll
    for (int o = 1; o < 64; o <<= 1) v += __shfl_xor(v, o);
    return v;
}
__device__ __forceinline__ int cond_of_tile(int pm) { return pm < 32 ? 0 : 1 + ((pm - 32) >> 3); }
__device__ __forceinline__ int cond_of_row(int row) { return row < M_CTX ? 0 : 1 + ((row - M_CTX) >> 11); }

#define XB_TMO      128
#define XB_XCNT(j)  (256  + 64 * (j))
#define XB_XSUB(j)  (1280 + 64 * (j))
#define XB_XGEN(j)  (2304 + 64 * (j))
#define XB_TOP      3328
#define XB_TOPGEN   3392
#define XCD_BAR_WORDS 3456
#define XB_SPIN_CAP (1u << 20)
__device__ __forceinline__ unsigned xb_ld(unsigned* p)              { return __hip_atomic_load(p, __ATOMIC_RELAXED, __HIP_MEMORY_SCOPE_AGENT); }
__device__ __forceinline__ unsigned xb_add(unsigned* p, unsigned v) { return __hip_atomic_fetch_add(p, v, __ATOMIC_RELAXED, __HIP_MEMORY_SCOPE_AGENT); }
__device__ __forceinline__ unsigned xb_xcc_id() { return (unsigned)__builtin_amdgcn_s_getreg((3 << 11) | 20) & 0xFu; }
#define XB_SPIN(cond, bar) do { unsigned _sp = 0; while (cond) { __builtin_amdgcn_s_sleep(1); \
    if ((++_sp & 255u) == 0u) { if (xb_ld(&(bar)[XB_TMO])) break; if (_sp > XB_SPIN_CAP) { atomicAdd(&(bar)[XB_TMO], 1u); break; } } } } while (0)
struct XcdBarrier { unsigned* bar; unsigned x; volatile LAS unsigned* st; };
__device__ __forceinline__ XcdBarrier xcd_barrier_post(unsigned* bar, volatile LAS unsigned* st) {
    XcdBarrier b; b.bar = bar; b.x = xb_xcc_id(); b.st = st;
    if (threadIdx.x == 0) (void)xb_add(&bar[XB_XCNT(b.x)], 1u);
    return b;
}
__device__ __forceinline__ void xcd_barrier_complete(unsigned* bar, unsigned x, unsigned& nloc, unsigned& nx) {
    const unsigned G = gridDim.x * gridDim.y * gridDim.z;
    unsigned sum, cnt, mine, sp = 0u;
    for (;;) {
        sum = 0u; cnt = 0u; mine = 0u;
#pragma unroll
        for (unsigned j = 0; j < 16; ++j) { const unsigned c = xb_ld(&bar[XB_XCNT(j)]); sum += c; cnt += (c > 0u) ? 1u : 0u; mine = (j == x) ? c : mine; }
        if (sum == G) break;
        __builtin_amdgcn_s_sleep(1);
        if ((++sp & 255u) == 0u) { if (xb_ld(&bar[XB_TMO])) break; if (sp > XB_SPIN_CAP) { atomicAdd(&bar[XB_TMO], 1u); break; } }
    }
    nloc = mine > 0u ? mine : 1u; nx = cnt > 0u ? cnt : 1u;
}
__device__ __forceinline__ void xcd_barrier(const XcdBarrier& b) {
    asm volatile("s_waitcnt vmcnt(0)" ::: "memory");
    __syncthreads();
    if (threadIdx.x == 0) {
        unsigned* bar = b.bar;
        __builtin_amdgcn_s_waitcnt(0);
        unsigned nloc = b.st[0], nx = b.st[1];
        if (nloc == 0u) { xcd_barrier_complete(bar, b.x, nloc, nx); b.st[0] = nloc; b.st[1] = nx; }
        const unsigned old = xb_add(&bar[XB_XSUB(b.x)], 1u);
        const unsigned gen = old / nloc;
        if (old + 1u == (gen + 1u) * nloc) {
            __builtin_amdgcn_fence(__ATOMIC_RELEASE, "agent");
            asm volatile("s_waitcnt vmcnt(0)" ::: "memory");
            const unsigned og = xb_add(&bar[XB_TOP], 1u);
            const unsigned tg = og / nx;
            if (og + 1u == (tg + 1u) * nx) xb_add(&bar[XB_TOPGEN], 1u);
            else XB_SPIN(xb_ld(&bar[XB_TOPGEN]) == tg, bar);
            __builtin_amdgcn_fence(__ATOMIC_ACQUIRE, "agent");
            xb_add(&bar[XB_XGEN(b.x)], 1u);
            asm volatile("s_waitcnt vmcnt(0)" ::: "memory");
        } else {
            XB_SPIN(xb_ld(&bar[XB_XGEN(b.x)]) == gen, bar);
            __builtin_amdgcn_fence(__ATOMIC_ACQUIRE, "agent");
            asm volatile("s_waitcnt vmcnt(0)" ::: "memory");
        }
    }
    __syncthreads();
}

namespace pg8 {
constexpr int BM = 256, BK = 64, HALF = 128, HTB = HALF * BK * 2, STAGE_BYTES = 8 * HTB, NXCD = 8, WGM = 8;
__host__ __device__ __forceinline__ int lds_byte(int r, int c) { const int st = (r >> 4) * 2 + (c >> 5), rr = r & 15, cc = c & 31, ob = rr * 64 + cc * 2; return st * 1024 + (ob ^ (((ob >> 9) & 1) << 5)); }
__host__ __device__ __forceinline__ void stage_rc(int b, int& R, int& C) { const int st = b / 1024, sb = b % 1024, swz = sb ^ (((sb >> 9) & 1) << 5); R = (st >> 1) * 16 + swz / 64; C = (st & 1) * 32 + (swz % 64) / 2; }
__host__ __device__ __forceinline__ int perm32(int rho) { const int n = rho >> 4, i = rho & 15; return 8 * (i >> 2) + 4 * n + (i & 3); }
struct Unit { int pm, pn; };
struct Gemm { const bf16_t* A; const bf16_t* Bt; int M, N, K; };
struct StaticOrder {
    int nM, nN, nwg, G, c;
    __host__ __device__ void init(int M, int N, int G_, int c_) { nM = M / BM; nN = N / BM; nwg = nM * nN; G = G_; c = c_; }
    __host__ __device__ bool next(int i, Unit& u) const {
        const long L = (long)i * G + c; if (L >= nwg) return false;
        int wgid = (int)L; { const int q = nwg / NXCD, r = nwg % NXCD, xcd = wgid % NXCD, off = wgid / NXCD; wgid = (xcd < r ? xcd * (q + 1) : r * (q + 1) + (xcd - r) * q) + off; }
        const int nig = WGM * nN, gid = wgid / nig, fm = gid * WGM, gsz = (nM - fm) < WGM ? (nM - fm) : WGM;
        u.pm = fm + ((wgid % nig) % gsz); u.pn = (wgid % nig) / gsz; return true;
    }
};
template <class Epi>
__device__ __forceinline__ void gemm_phase(lptr lds, const int tid, const Gemm g, const StaticOrder& S, const Epi& E) {
    const int wid = __builtin_amdgcn_readfirstlane(tid >> 6), lane = tid & 63, wr = wid >> 2, wc = wid & 3, fr = lane & 15, fq = lane >> 4;
    const int K = g.K, nt = K / BK;
    unsigned voffA[2], voffB[2];
#pragma unroll
    for (int i = 0; i < 2; ++i) { int R, C; stage_rc(tid * 16 + i * 8192, R, C); const int Rb = (R & ~31) + perm32(R & 31);
        voffA[i] = (unsigned)(R * K + C) * 2u; voffB[i] = (unsigned)(Rb * K + C) * 2u; }
    const size_t kstep = (size_t)(BK * 2);
    const size_t hstep = (size_t)HALF * K * 2;
    const size_t tstep = 2 * hstep;
    const unsigned ldsw = (unsigned)wid * 1024u;
    const int aoff = lds_byte(wr * 64 + fr, fq * 8), boff = lds_byte(wc * 32 + fr, fq * 8);
#define PG8_SA(b, h) (((b) * 2 + (h)) * HTB)
#define PG8_SB(b, h) ((4 + (b) * 2 + (h)) * HTB)
#define PG8_STAGE(bufoff, gbase, voff) do { _Pragma("unroll") for (int _i = 0; _i < 2; ++_i) \
        __builtin_amdgcn_global_load_lds((const unsigned*)((const char*)(gbase) + (voff)[_i]), (LAS unsigned*)(lds + (bufoff) + ldsw + _i * 8192), 16, 0, 0); } while (0)
#define PG8_LDA(dst, b, h) do { _Pragma("unroll") for (int m = 0; m < 4; ++m) _Pragma("unroll") for (int k = 0; k < 2; ++k) dst[m][k] = *(const LAS bf16x8*)(lds + PG8_SA(b, h) + aoff + m * 2048 + k * 1024); } while (0)
#define PG8_LDB(dst, b, h) do { _Pragma("unroll") for (int n = 0; n < 2; ++n) _Pragma("unroll") for (int k = 0; k < 2; ++k) dst[n][k] = *(const LAS bf16x8*)(lds + PG8_SB(b, h) + boff + n * 2048 + k * 1024); } while (0)
#define PG8_MMA(ai, bj, At, Bt) do { __builtin_amdgcn_s_setprio(1); _Pragma("unroll") for (int m = 0; m < 4; ++m) _Pragma("unroll") for (int n = 0; n < 2; ++n) _Pragma("unroll") for (int k = 0; k < 2; ++k) \
        acc[ai][bj][m][n] = __builtin_amdgcn_mfma_f32_16x16x32_bf16(Bt[n][k], At[m][k], acc[ai][bj][m][n], 0, 0, 0); __builtin_amdgcn_s_setprio(0); } while (0)
#define PG8_WAIT_V(n) asm volatile("s_waitcnt vmcnt(" #n ")" ::: "memory")
#define PG8_WAIT_L(n) asm volatile("s_waitcnt lgkmcnt(" #n ")" ::: "memory")
#define PG8_BAR __builtin_amdgcn_s_barrier()
#define PG8_SCHED __builtin_amdgcn_sched_barrier(0)
    Unit cur, nxt; int ui = 0;
    if (!S.next(0, cur)) return;
    f32x4 acc[2][2][4][2];
#pragma unroll
    for (int a = 0; a < 2; ++a)
#pragma unroll
        for (int b = 0; b < 2; ++b)
#pragma unroll
            for (int m = 0; m < 4; ++m)
#pragma unroll
                for (int n = 0; n < 2; ++n) acc[a][b][m][n] = (f32x4){0.f, 0.f, 0.f, 0.f};
    bf16x8 At[4][2], B0[2][2], B1[2][2];
    const char* cA = (const char*)g.A + (size_t)cur.pm * tstep; const char* cB = (const char*)g.Bt + (size_t)cur.pn * tstep;
    PG8_STAGE(PG8_SB(0, 0), cB, voffB); PG8_STAGE(PG8_SB(0, 1), cB + hstep, voffB); PG8_STAGE(PG8_SA(0, 0), cA, voffA); PG8_STAGE(PG8_SA(0, 1), cA + hstep, voffA);
    if (wr == 1) PG8_BAR;
    PG8_WAIT_V(2); PG8_BAR;
    PG8_STAGE(PG8_SB(1, 0), cB + kstep, voffB); PG8_STAGE(PG8_SA(1, 0), cA + kstep, voffA); PG8_STAGE(PG8_SB(1, 1), cB + hstep + kstep, voffB);
    PG8_WAIT_V(6); PG8_BAR;
    for (;;) {
        const bool has_next = S.next(ui + 1, nxt);
        const char* nA = has_next ? (const char*)g.A + (size_t)nxt.pm * tstep : cA; const char* nB = has_next ? (const char*)g.Bt + (size_t)nxt.pn * tstep : cB;
        for (int t = 0; t < nt; t += 2) {
            const bool last = (t == nt - 2);
            const char* a1 = cA + (size_t)(t + 1) * kstep;
            const char* a2 = last ? nA : cA + (size_t)(t + 2) * kstep; const char* b2 = last ? nB : cB + (size_t)(t + 2) * kstep;
            const char* a3 = a2 + kstep; const char* b3 = b2 + kstep;
            PG8_LDB(B0, 0, 0); PG8_LDB(B1, 0, 1); PG8_SCHED; PG8_LDA(At, 0, 0); PG8_STAGE(PG8_SA(1, 1), a1 + hstep, voffA);
            PG8_WAIT_V(8); PG8_WAIT_L(0); PG8_BAR; PG8_MMA(0, 0, At, B0); PG8_MMA(0, 1, At, B1); PG8_BAR; PG8_SCHED;
            PG8_LDA(At, 0, 1); PG8_STAGE(PG8_SB(0, 0), b2, voffB); PG8_STAGE(PG8_SB(0, 1), b2 + hstep, voffB); PG8_STAGE(PG8_SA(0, 0), a2, voffA);
            PG8_WAIT_V(8); PG8_WAIT_L(0); PG8_BAR; PG8_MMA(1, 0, At, B0); PG8_MMA(1, 1, At, B1); PG8_BAR; PG8_SCHED;
            PG8_LDB(B0, 1, 0); PG8_LDB(B1, 1, 1); PG8_SCHED; PG8_LDA(At, 1, 0); PG8_STAGE(PG8_SA(0, 1), a2 + hstep, voffA);
            PG8_WAIT_V(8); PG8_WAIT_L(0); PG8_BAR; PG8_MMA(0, 0, At, B0); PG8_MMA(0, 1, At, B1); PG8_BAR; PG8_SCHED;
            PG8_LDA(At, 1, 1); PG8_STAGE(PG8_SB(1, 0), b3, voffB); PG8_STAGE(PG8_SB(1, 1), b3 + hstep, voffB); PG8_STAGE(PG8_SA(1, 0), a3, voffA);
            PG8_WAIT_V(8); PG8_WAIT_L(0); PG8_BAR; PG8_MMA(1, 0, At, B0); PG8_MMA(1, 1, At, B1); PG8_BAR; PG8_SCHED;
        }
        if (wr == 0) PG8_BAR;
        E(acc, cur, wr, wc, fr, fq);
        if (!has_next) break;
#pragma unroll
        for (int a = 0; a < 2; ++a)
#pragma unroll
            for (int b = 0; b < 2; ++b)
#pragma unroll
                for (int m = 0; m < 4; ++m)
#pragma unroll
                    for (int n = 0; n < 2; ++n) acc[a][b][m][n] = (f32x4){0.f, 0.f, 0.f, 0.f};
        cur = nxt; cA = nA; cB = nB; ++ui;
        if (wr == 1) PG8_BAR;
    }
    PG8_WAIT_V(0);
    PG8_BAR;
#undef PG8_SA
#undef PG8_SB
#undef PG8_STAGE
#undef PG8_LDA
#undef PG8_LDB
#undef PG8_MMA
#undef PG8_WAIT_V
#undef PG8_WAIT_L
#undef PG8_BAR
#undef PG8_SCHED
}
}
typedef f32x4 AccT[2][2][4][2];

struct EpiIn {
    unsigned char* ws; int l;
    __device__ __forceinline__ void operator()(const AccT& acc, const pg8::Unit& u, int wr, int wc, int fr, int fq) const {
        const int j = l >> 1;
        const float* ss = (const float*)(ws + WS_SS) + (size_t)(2 * l) * M_TOT; const float* bias = (const float*)(ws + WS_BIAS_IN) + (size_t)j * NCOND * A_IN; const float* lb = (const float*)(ws + WS_LB) + (size_t)j * 2048;
        bf16_t* Q = (bf16_t*)(ws + WS_HQ); bf16_t* KF = (bf16_t*)(ws + WS_HKF); bf16_t* KB = (bf16_t*)(ws + WS_HKB); bf16_t* V = (bf16_t*)(ws + WS_HV); bf16_t* SG = (bf16_t*)(ws + WS_A2);
        unsigned short* GF = (unsigned short*)(ws + WS_HGF); unsigned short* GB = (unsigned short*)(ws + WS_HGB);
        const int cond = cond_of_tile(u.pm), type = u.pn >> 2, chb = (u.pn & 3) * 256 + wc * 32 + 8 * fq;
        const float* bp = bias + (size_t)cond * A_IN + type * 1024;
#pragma unroll
        for (int ai = 0; ai < 2; ++ai)
#pragma unroll
            for (int m = 0; m < 4; ++m) {
                const int row = u.pm * 256 + ai * 128 + wr * 64 + m * 16 + fr;
                const float rstd = rsqrtf(ss[row] * (1.f / DM) + EPS);
#pragma unroll
                for (int bj = 0; bj < 2; ++bj) {
                    const int ch = chb + bj * 128;
                    const f32x4 b0 = *(const f32x4*)(bp + ch), b1 = *(const f32x4*)(bp + ch + 4);
                    float z[8];
#pragma unroll
                    for (int e = 0; e < 4; ++e) { z[e] = acc[ai][bj][m][0][e] * rstd + b0[e]; z[4 + e] = acc[ai][bj][m][1][e] * rstd + b1[e]; }
                    const size_t o = (size_t)row * DM + ch;
                    if (type == 0 || type == 4) {
                        u32x4 w; w.x = pk_bf16(silu_f(z[0]), silu_f(z[1])); w.y = pk_bf16(silu_f(z[2]), silu_f(z[3])); w.z = pk_bf16(silu_f(z[4]), silu_f(z[5])); w.w = pk_bf16(silu_f(z[6]), silu_f(z[7]));
                        *(u32x4*)((type == 0 ? Q : SG) + o) = w;
                    } else if (type == 3) {
                        u32x4 w; w.x = pk_bf16(z[0], z[1]); w.y = pk_bf16(z[2], z[3]); w.z = pk_bf16(z[4], z[5]); w.w = pk_bf16(z[6], z[7]);
                        *(u32x4*)(V + o) = w;
                    } else {
                        const float* lp = lb + (type - 1) * 1024 + ch;
                        const f32x4 l0 = *(const f32x4*)lp, l1 = *(const f32x4*)(lp + 4);
                        float kk[8], lg[8];
#pragma unroll
                        for (int e = 0; e < 8; ++e) {
                            const float lbv = e < 4 ? l0[e] : l1[e - 4];
                            const float zz = fminf(fmaxf(z[e], -40.f), 40.f);
                            const float en = fast_exp2(-zz * LOG2E);
                            const float sg = fast_rcp(1.f + en);
                            const float om = en * sg;
                            const float f = lbv + (1.f - lbv) * sg;
                            kk[e] = (1.f - lbv) * om;
                            lg[e] = __builtin_amdgcn_logf(f);
                        }
                        u32x4 w; w.x = pk_bf16(kk[0], kk[1]); w.y = pk_bf16(kk[2], kk[3]); w.z = pk_bf16(kk[4], kk[5]); w.w = pk_bf16(kk[6], kk[7]);
                        u32x4 h; h.x = pk_f16(lg[0], lg[1]); h.y = pk_f16(lg[2], lg[3]); h.z = pk_f16(lg[4], lg[5]); h.w = pk_f16(lg[6], lg[7]);
                        *(u32x4*)((type == 1 ? KF : KB) + o) = w;
                        *(u32x4*)((type == 1 ? GF : GB) + o) = h;
                    }
                }
            }
    }
};

struct EpiQkv {
    unsigned char* ws; float* out; int l;
    __device__ __forceinline__ void operator()(const AccT& acc, const pg8::Unit& u, int wr, int wc, int fr, int fq) const {
        const int j = l >> 1;
        const float* ss = (const float*)(ws + WS_SS) + (size_t)(2 * l) * M_TOT; const float* bias = (const float*)(ws + WS_BIAS_QKV) + (size_t)j * NCOND * QKV_N; const float* rope = (const float*)(ws + WS_ROPE);
        bf16_t* Qa = (bf16_t*)(ws + WS_AQ); bf16_t* Ka = (bf16_t*)(ws + WS_AK); bf16_t* VaT = (bf16_t*)(ws + WS_AVT); float* outK = out + OUT_CK; float* outV = out + OUT_CV;
        const int cond = cond_of_tile(u.pm);
        const bool lat = u.pm >= 32;
        const float* bp = bias + (size_t)cond * QKV_N + u.pn * 256;
        const float qscale = 0.08838834764831845f * LOG2E;
#pragma unroll
        for (int ai = 0; ai < 2; ++ai)
#pragma unroll
            for (int m = 0; m < 4; ++m) {
                const int row = u.pm * 256 + ai * 128 + wr * 64 + m * 16 + fr;
                const float rstd = rsqrtf(ss[row] * (1.f / DM) + EPS);
                const int tl = (row - M_CTX) & 2047;
#pragma unroll
                for (int bj = 0; bj < 2; ++bj) {
                    const int cl = bj * 128 + wc * 32 + 8 * fq;
                    const f32x4 b0 = *(const f32x4*)(bp + cl), b1 = *(const f32x4*)(bp + cl + 4);
                    float z[8];
#pragma unroll
                    for (int e = 0; e < 4; ++e) { z[e] = acc[ai][bj][m][0][e] * rstd + b0[e]; z[4 + e] = acc[ai][bj][m][1][e] * rstd + b1[e]; }
                    if (u.pn < 5) {
                        const int hl = cl & 127, ax = hl >> 6, j0 = (hl & 63) >> 1;
                        if (u.pn == 4 && !lat) {
                            const int b = row >> 8, t = row & 255, kvh = cl >> 7;
                            float* op = outK + ((size_t)((b * 2 + j) * 256 + t) * 2 + kvh) * 128 + ax * 64 + j0;
                            *(f32x4*)op = (f32x4){z[0], z[2], z[4], z[6]};
                            *(f32x4*)(op + 32) = (f32x4){z[1], z[3], z[5], z[7]};
                        }
                        if (lat) {
                            const int pos = ax ? (tl & 63) : (tl >> 6);
                            const float* cp = rope + (ax * 64 + pos) * 32 + j0;
                            const f32x4 cs = *(const f32x4*)cp, sn = *(const f32x4*)(cp + 2 * 64 * 32);
#pragma unroll
                            for (int e = 0; e < 4; ++e) { const float x1 = z[2 * e], x2 = z[2 * e + 1]; z[2 * e] = x1 * cs[e] - x2 * sn[e]; z[2 * e + 1] = x1 * sn[e] + x2 * cs[e]; }
                        }
                        if (u.pn < 4) {
#pragma unroll
                            for (int e = 0; e < 8; ++e) z[e] *= qscale;
                            u32x4 w; w.x = pk_bf16(z[0], z[1]); w.y = pk_bf16(z[2], z[3]); w.z = pk_bf16(z[4], z[5]); w.w = pk_bf16(z[6], z[7]);
                            *(u32x4*)(Qa + (size_t)row * DM + u.pn * 256 + cl) = w;
                        } else {
                            u32x4 w; w.x = pk_bf16(z[0], z[1]); w.y = pk_bf16(z[2], z[3]); w.z = pk_bf16(z[4], z[5]); w.w = pk_bf16(z[6], z[7]);
                            *(u32x4*)(Ka + (size_t)row * 256 + cl) = w;
                        }
                    } else {
                        const int kvh = cl >> 7, d0 = cl & 127;
                        size_t vb; int T;
                        if (!lat) { const int b = row >> 8, t = row & 255; T = 256; vb = ((size_t)(b * 2 + kvh) * 128 + d0) * 256 + t;
                            float* op = outV + ((size_t)((b * 2 + j) * 256 + t) * 2 + kvh) * 128 + d0;
                            *(f32x4*)op = (f32x4){z[0], z[1], z[2], z[3]}; *(f32x4*)(op + 4) = (f32x4){z[4], z[5], z[6], z[7]};
                        } else { const int b = (row - M_CTX) >> 11; T = 2048; vb = (size_t)2097152 + ((size_t)(b * 2 + kvh) * 128 + d0) * 2048 + tl; }
#pragma unroll
                        for (int e = 0; e < 8; ++e) VaT[vb + (size_t)e * T] = to_bf16(z[e]);
                    }
                }
            }
    }
};

struct EpiRes {
    unsigned char* ws; float* x; inptr_t in; int l; int down;
    __device__ __forceinline__ void operator()(const AccT& acc, const pg8::Unit& u, int wr, int wc, int fr, int fq) const {
        const float* mod = (const float*)(ws + WS_MOD);
        const bool lastl = down && l == 3;
        const float* gate = mod + (size_t)l * 6144 + (down ? 5120 : 2048);
        const float* nw = down ? in[9] + (size_t)(l + 1) * DM : in[10] + (size_t)l * DM;
        const float* sc = lastl ? nullptr : (down ? mod + (size_t)(l + 1) * 6144 + 1024 : mod + (size_t)l * 6144 + 4096);
        float* ssout = (float*)(ws + WS_SS) + (size_t)(2 * l + 1 + down) * M_TOT;
        bf16_t* XA = lastl ? nullptr : (bf16_t*)(ws + WS_XA);
        const int cond = cond_of_tile(u.pm);
        const float* gp = gate + (size_t)cond * (4 * 6144); const float* sp = sc ? sc + (size_t)cond * (4 * 6144) : nullptr;
#pragma unroll
        for (int ai = 0; ai < 2; ++ai)
#pragma unroll
            for (int m = 0; m < 4; ++m) {
                const int row = u.pm * 256 + ai * 128 + wr * 64 + m * 16 + fr;
                float sq = 0.f;
#pragma unroll
                for (int bj = 0; bj < 2; ++bj) {
                    const int col = u.pn * 256 + bj * 128 + wc * 32 + 8 * fq;
                    float* xp = x + (size_t)row * DM + col;
                    const f32x4 g0 = *(const f32x4*)(gp + col), g1 = *(const f32x4*)(gp + col + 4);
                    f32x4 x0 = *(const f32x4*)xp, x1 = *(const f32x4*)(xp + 4);
                    x0 += g0 * acc[ai][bj][m][0]; x1 += g1 * acc[ai][bj][m][1];
                    *(f32x4*)xp = x0; *(f32x4*)(xp + 4) = x1;
                    sq += (x0[0] * x0[0] + x0[1] * x0[1]) + (x0[2] * x0[2] + x0[3] * x0[3]) + (x1[0] * x1[0] + x1[1] * x1[1]) + (x1[2] * x1[2] + x1[3] * x1[3]);
                    if (XA) {
                        const f32x4 n0 = *(const f32x4*)(nw + col), n1 = *(const f32x4*)(nw + col + 4);
                        const f32x4 s0 = *(const f32x4*)(sp + col), s1 = *(const f32x4*)(sp + col + 4);
                        const f32x4 a0 = x0 * n0 * (s0 + 1.f), a1 = x1 * n1 * (s1 + 1.f);
                        u32x4 w; w.x = pk_bf16(a0[0], a0[1]); w.y = pk_bf16(a0[2], a0[3]); w.z = pk_bf16(a1[0], a1[1]); w.w = pk_bf16(a1[2], a1[3]);
                        *(u32x4*)(XA + (size_t)row * DM + col) = w;
                    }
                }
                sq += __shfl_xor(sq, 16); sq += __shfl_xor(sq, 32);
                if (fq == 0) atomicAdd(ssout + row, sq);
            }
    }
};

struct EpiGU {
    unsigned char* ws; int l;
    __device__ __forceinline__ void operator()(const AccT& acc, const pg8::Unit& u, int wr, int wc, int fr, int fq) const {
        const float* ss = (const float*)(ws + WS_SS) + (size_t)(2 * l + 1) * M_TOT; const float* bias = (const float*)(ws + WS_BIAS_GU) + (size_t)l * NCOND * GU_N; bf16_t* H = (bf16_t*)(ws + WS_H);
        const int cond = cond_of_tile(u.pm);
        const float* bp = bias + (size_t)cond * GU_N;
#pragma unroll
        for (int ai = 0; ai < 2; ++ai)
#pragma unroll
            for (int m = 0; m < 4; ++m) {
                const int row = u.pm * 256 + ai * 128 + wr * 64 + m * 16 + fr;
                const float rstd = rsqrtf(ss[row] * (1.f / DM) + EPS);
#pragma unroll
                for (int bj = 0; bj < 2; ++bj) {
                    const int col = u.pn * 256 + bj * 128 + wc * 32 + 8 * fq;
                    const f32x4 b0 = *(const f32x4*)(bp + col), b1 = *(const f32x4*)(bp + col + 4);
                    float hv[4];
#pragma unroll
                    for (int e = 0; e < 4; ++e) { const float gz = acc[ai][bj][m][0][e] * rstd + b0[e], uz = acc[ai][bj][m][1][e] * rstd + b1[e]; hv[e] = silu_f(gz) * uz; }
                    u32x2 w; w.x = pk_bf16(hv[0], hv[1]); w.y = pk_bf16(hv[2], hv[3]);
                    *(u32x2*)(H + (size_t)row * D_FF + (col >> 1)) = w;
                }
            }
    }
};

struct Args { const float* in[21]; float* out; unsigned char* ws; int ph_lo, ph_hi; };
struct Frame { lptr lds; int tid, lane, wave, G, bid; inptr_t in; float* out; unsigned char* ws; };

template <class RowMap>
__device__ __forceinline__ void transpose_item(const float* W, int K, int N, bf16_t* WT, LAS float* scr, int item, int lane, RowMap rm) {
    const int nblk = N / 32, kb = item / nblk, nb = item % nblk, k0 = 64 * kb, n0 = 32 * nb;
#pragma unroll 8
    for (int i = 0; i < 32; ++i) { const int kk = 2 * i + (lane >> 5); scr[kk * 33 + (lane & 31)] = W[(size_t)(k0 + kk) * N + n0 + (lane & 31)]; }
    asm volatile("s_waitcnt lgkmcnt(0)" ::: "memory");
    const int c = lane & 7;
#pragma unroll
    for (int jj = 0; jj < 4; ++jj) { const int n = (lane >> 3) + 8 * jj; const LAS float* s = scr + (8 * c) * 33 + n;
        u32x4 o; o.x = pk_bf16(s[0 * 33], s[1 * 33]); o.y = pk_bf16(s[2 * 33], s[3 * 33]); o.z = pk_bf16(s[4 * 33], s[5 * 33]); o.w = pk_bf16(s[6 * 33], s[7 * 33]);
        *(u32x4*)(WT + (size_t)rm(n0 + n) * K + k0 + 8 * c) = o; }
    asm volatile("s_waitcnt lgkmcnt(0)" ::: "memory");
}
struct RmId { __device__ __forceinline__ int operator()(int n) const { return n; } };
struct RmQkv { __device__ __forceinline__ int operator()(int n) const { if (n >= 1280) return n; const int hb = n & ~127, hl = n & 127, ax = hl >> 6, r = hl & 63, p = r >> 5, jj = r & 31; return hb + ax * 64 + 2 * jj + p; } };
struct RmGU { __device__ __forceinline__ int operator()(int n) const { const int isu = n >= D_FF, i = isu ? n - D_FF : n; return 8 * (i >> 2) + 4 * isu + (i & 3); } };

__device__ __forceinline__ void phase0a(Frame& F) {
    const int gw = F.bid * NWAVES + F.wave, NGW = F.G * NWAVES;
    const inptr_t in = F.in;
    float* mod = (float*)(F.ws + WS_MOD);
    {
        LAS float* sc = (LAS float*)F.lds;
        for (int i = F.tid; i < NCOND * DM; i += NTHREADS) { const int c = i >> 10, k = i & 1023; const float v = c == 0 ? in[6][k] : in[5][(c - 1) * DM + k]; sc[i] = v / (1.f + __expf(-v)); }
        __syncthreads();
        for (int it = F.bid; it < 768; it += F.G) {
            const int nc = it % 6, kc = (it / 6) & 31, l = it / 192;
            const int n = nc * 1024 + 2 * F.tid, k0 = kc * 32;
            const float* wp = in[7] + ((size_t)l * DM + k0) * 6144 + n;
            float a[NCOND][2];
#pragma unroll
            for (int c = 0; c < NCOND; ++c) { a[c][0] = 0.f; a[c][1] = 0.f; }
#pragma unroll 8
            for (int k = 0; k < 32; ++k) { const f32x2 w = *(const f32x2*)(wp + (size_t)k * 6144);
#pragma unroll
                for (int c = 0; c < NCOND; ++c) { const float s = sc[c * DM + k0 + k]; a[c][0] += s * w.x; a[c][1] += s * w.y; } }
            if (kc == 0) { const f32x2 b = *(const f32x2*)(in[8] + (size_t)l * 6144 + n);
#pragma unroll
                for (int c = 0; c < NCOND; ++c) { a[c][0] += b.x; a[c][1] += b.y; } }
#pragma unroll
            for (int c = 0; c < NCOND; ++c) { float* mp = mod + (size_t)(c * 4 + l) * 6144 + n; atomicAdd(mp, a[c][0]); atomicAdd(mp + 1, a[c][1]); }
        }
        __syncthreads();
    }
    {
        LAS float* scr = (LAS float*)(F.lds + F.wave * 16384);
        constexpr int I_IN = 16 * 160, I_SQ = 16 * 32, I_QKV = 16 * 48, I_GU = 16 * 176, I_DN = 44 * 32;
        constexpr int T0 = 2 * I_IN, T1 = T0 + 2 * I_SQ, T2 = T1 + 2 * I_QKV, T3 = T2 + 2 * I_SQ, T4 = T3 + 4 * I_GU, T5 = T4 + 4 * I_DN;
        for (int it = gw; it < T5; it += NGW) {
            if (it < T0) { const int j = it / I_IN, r = it % I_IN; transpose_item(in[14] + (size_t)j * DM * A_IN, DM, A_IN, (bf16_t*)(F.ws + WS_W_IN) + (size_t)j * A_IN * DM, scr, r, F.lane, RmId()); }
            else if (it < T1) { const int q = it - T0, j = q / I_SQ, r = q % I_SQ; transpose_item(in[17] + (size_t)j * DM * DM, DM, DM, (bf16_t*)(F.ws + WS_W_OUTA) + (size_t)j * DM * DM, scr, r, F.lane, RmId()); }
            else if (it < T2) { const int q = it - T1, j = q / I_QKV, r = q % I_QKV; transpose_item(in[18] + (size_t)j * DM * QKV_N, DM, QKV_N, (bf16_t*)(F.ws + WS_W_QKV) + (size_t)j * QKV_N * DM, scr, r, F.lane, RmQkv()); }
            else if (it < T3) { const int q = it - T2, j = q / I_SQ, r = q % I_SQ; transpose_item(in[19] + (size_t)j * DM * DM, DM, DM, (bf16_t*)(F.ws + WS_W_OUTB) + (size_t)j * DM * DM, scr, r, F.lane, RmId()); }
            else if (it < T4) { const int q = it - T3, l = q / I_GU, r = q % I_GU; transpose_item(in[12] + (size_t)l * DM * GU_N, DM, GU_N, (bf16_t*)(F.ws + WS_W_GU) + (size_t)l * GU_N * DM, scr, r, F.lane, RmGU()); }
            else { const int q = it - T4, l = q / I_DN, r = q % I_DN; transpose_item(in[13] + (size_t)l * D_FF * DM, D_FF, DM, (bf16_t*)(F.ws + WS_W_DN) + (size_t)l * DM * D_FF, scr, r, F.lane, RmId()); }
        }
    }
    const int gt = F.bid * NTHREADS + F.tid, NGT = F.G * NTHREADS;
    for (int i = gt; i < 2 * 1024; i += NGT) { const float a = in[15][i], b = in[15][2048 + i]; const float mx = fmaxf(a, b), ea = __expf(a - mx), eb = __expf(b - mx);
        float* lb = (float*)(F.ws + WS_LB); lb[i] = 0.f; lb[2048 + i] = eb / (ea + eb); }
    for (int i = gt; i < 2 * 64 * 32; i += NGT) { const int jx = i & 31, pos = (i >> 5) & 63; const float inv = exp2f(-(float)jx * (13.287712379549449f / 32.f)); const float ang = (float)pos * inv;
        float* rp = (float*)(F.ws + WS_ROPE); rp[i] = cosf(ang); rp[2 * 64 * 32 + i] = sinf(ang); }
    for (int i = gt; i < 4 * 2 * 512 * 2 * 16; i += NGT) {
        const int rowid = i >> 4, o0 = (i & 15) * 8; float v[8];
#pragma unroll
        for (int e = 0; e < 8; ++e) { const int hl = o0 + e, ax = hl >> 6, r = hl & 63, jj = r >> 1, p = r & 1; v[e] = in[2][(size_t)rowid * 128 + ax * 64 + 32 * p + jj]; }
        u32x4 w; w.x = pk_bf16(v[0], v[1]); w.y = pk_bf16(v[2], v[3]); w.z = pk_bf16(v[4], v[5]); w.w = pk_bf16(v[6], v[7]);
        *(u32x4*)((bf16_t*)(F.ws + WS_CK) + (size_t)rowid * 128 + o0) = w;
    }
    for (int i = gt; i < 4 * 2 * 2 * 64 * 128; i += NGT) {
        const int d = i & 127, p8 = (i >> 7) & 63, kvh = (i >> 13) & 1, bj = i >> 14; float v[8];
#pragma unroll
        for (int e = 0; e < 8; ++e) v[e] = in[3][((size_t)(bj * 512 + p8 * 8 + e) * 2 + kvh) * 128 + d];
        u32x4 w; w.x = pk_bf16(v[0], v[1]); w.y = pk_bf16(v[2], v[3]); w.z = pk_bf16(v[4], v[5]); w.w = pk_bf16(v[6], v[7]);
        *(u32x4*)((bf16_t*)(F.ws + WS_CVT) + ((size_t)(bj * 2 + kvh) * 128 + d) * 512 + p8 * 8) = w;
    }
    for (int row = gw; row < M_TOT; row += NGW) {
        const float* src = row < M_CTX ? in[0] + (size_t)row * DM : in[1] + (size_t)(row - M_CTX) * DM;
        float* dst = F.out + (size_t)row * DM; float s = 0.f;
#pragma unroll
        for (int jx = 0; jx < 4; ++jx) { const f32x4 v = *(const f32x4*)(src + 4 * F.lane + 256 * jx); *(f32x4*)(dst + 4 * F.lane + 256 * jx) = v; s += (v.x * v.x + v.y * v.y) + (v.z * v.z + v.w * v.w); }
        s = wave_sum(s);
        if (F.lane == 0) ((float*)(F.ws + WS_SS))[row] = s;
    }
}

__device__ __forceinline__ void phase0b(Frame& F) {
    const int gw = F.bid * NWAVES + F.wave, NGW = F.G * NWAVES;
    const float* mod = (const float*)(F.ws + WS_MOD);
    for (int row = gw; row < M_TOT; row += NGW) {
        const int cond = cond_of_row(row);
        const float* xr = F.out + (size_t)row * DM; const float* nw = F.in[9]; const float* sc = mod + (size_t)(cond * 4 + 0) * 6144 + 1024;
        bf16_t* dst = (bf16_t*)(F.ws + WS_XA) + (size_t)row * DM;
#pragma unroll
        for (int jx = 0; jx < 4; ++jx) { const int k = 4 * F.lane + 256 * jx; const f32x4 v = *(const f32x4*)(xr + k), n = *(const f32x4*)(nw + k), s = *(const f32x4*)(sc + k);
            const f32x4 a = v * n * (s + 1.f); u32x2 w; w.x = pk_bf16(a[0], a[1]); w.y = pk_bf16(a[2], a[3]); *(u32x2*)(dst + k) = w; }
    }
    constexpr int R0 = 2 * A_IN, R1 = R0 + 2 * QKV_N, R2 = R1 + 4 * GU_N;
    int curset = -1; float sh[NCOND][16];
    for (int r = gw * 18; r < gw * 18 + 18 && r < R2; ++r) {
        int set, n, l, shoff; const bf16_t* wrow; float* bout; int N;
        if (r < R0) { const int j = r / A_IN; n = r % A_IN; set = j; l = 2 * j; shoff = 0; wrow = (const bf16_t*)(F.ws + WS_W_IN) + (size_t)r * DM; bout = (float*)(F.ws + WS_BIAS_IN) + (size_t)j * NCOND * A_IN; N = A_IN; }
        else if (r < R1) { const int q = r - R0, j = q / QKV_N; n = q % QKV_N; set = 2 + j; l = 2 * j + 1; shoff = 0; wrow = (const bf16_t*)(F.ws + WS_W_QKV) + (size_t)q * DM; bout = (float*)(F.ws + WS_BIAS_QKV) + (size_t)j * NCOND * QKV_N; N = QKV_N; }
        else { const int q = r - R1; l = q / GU_N; n = q % GU_N; set = 4 + l; shoff = 3072; wrow = (const bf16_t*)(F.ws + WS_W_GU) + (size_t)q * DM; bout = (float*)(F.ws + WS_BIAS_GU) + (size_t)l * NCOND * GU_N; N = GU_N; }
        if (set != curset) { curset = set;
#pragma unroll
            for (int c = 0; c < NCOND; ++c)
#pragma unroll
                for (int h = 0; h < 2; ++h) { const float* sp = mod + (size_t)(c * 4 + l) * 6144 + shoff + 512 * h + 8 * F.lane; const f32x4 a = *(const f32x4*)sp, b = *(const f32x4*)(sp + 4);
#pragma unroll
                    for (int e = 0; e < 4; ++e) { sh[c][8 * h + e] = a[e]; sh[c][8 * h + 4 + e] = b[e]; } } }
        float acc[NCOND] = {0.f, 0.f, 0.f, 0.f, 0.f};
#pragma unroll
        for (int h = 0; h < 2; ++h) { const u32x4 w = *(const u32x4*)(wrow + 512 * h + 8 * F.lane);
            const float wv[8] = {bf_lo(w.x), bf_hi(w.x), bf_lo(w.y), bf_hi(w.y), bf_lo(w.z), bf_hi(w.z), bf_lo(w.w), bf_hi(w.w)};
#pragma unroll
            for (int c = 0; c < NCOND; ++c)
#pragma unroll
                for (int e = 0; e < 8; ++e) acc[c] += sh[c][8 * h + e] * wv[e]; }
#pragma unroll
        for (int c = 0; c < NCOND; ++c) { const float s = wave_sum(acc[c]); if (F.lane == 0) bout[(size_t)c * N + n] = s; }
    }
}

constexpr int SC_QT = 0, SC_QH = SC_QT + 32 * 272, SC_KH = SC_QH + 16 * 272, SC_KO = SC_KH + 32 * 272, SC_KT = SC_KO + 16 * 272, SC_VT = SC_KT + 128 * 80,
              SC_SL = SC_VT + 128 * 80, SC_SC = SC_SL + 128 * 272, SC_TOT = SC_SC + 32 * 80, SC_DEC = SC_TOT + 8 * 128 * 4, SC_END = SC_DEC + 512;
static_assert(SC_END <= 131072, "scan lds");
struct ScanP { const bf16_t* Q; const bf16_t* V; bf16_t* KF; bf16_t* KB; const unsigned short* GF; const unsigned short* GB; const float* s_in; float* s_out; int j; };

__device__ __forceinline__ void scan_item(Frame& F, const ScanP& P, int rowbase, int T, int h, int dir, const float* s0, float* sfin) {
    const lptr L = F.lds; const int lane = F.lane, w = F.wave, g = lane >> 4, c = lane & 15;
    bf16_t* Kp = dir ? P.KB : P.KF; const unsigned short* Gp = dir ? P.GB : P.GF;
    f32x4 S[8];
#pragma unroll
    for (int a = 0; a < 8; ++a)
#pragma unroll
        for (int r = 0; r < 4; ++r) S[a][r] = s0 ? s0[(size_t)(16 * a + 4 * g + r) * 128 + 16 * w + c] : 0.f;
#pragma unroll
    for (int a = 0; a < 8; ++a) { u32x2 v; v.x = pk_bf16(S[a][0], S[a][1]); v.y = pk_bf16(S[a][2], S[a][3]); *(LAS u32x2*)(L + SC_SL + (16 * w + c) * 272 + (16 * a + 4 * g) * 2) = v; }
    if (F.tid < 256) { const int i = F.tid >> 4, s = 16 + (F.tid & 15); *(LAS bf16_t*)(L + SC_SC + i * 80 + s * 2) = 0; }
    const int nch = T / 32;
    const size_t hoff = (size_t)h * 128 + 2 * lane;
    unsigned q2[4], k2[4], g2[4], v2[4];
#define SCAN_LOAD(ch) do { _Pragma("unroll") for (int ii = 0; ii < 4; ++ii) { const int il = 32 * (ch) + 4 * w + ii; const int tok = dir ? (T - 1 - il) : il; \
        const size_t o = (size_t)(rowbase + tok) * DM + hoff; q2[ii] = *(const unsigned*)(P.Q + o); k2[ii] = *(const unsigned*)(Kp + o); g2[ii] = *(const unsigned*)(Gp + o); v2[ii] = *(const unsigned*)(P.V + o); } } while (0)
    SCAN_LOAD(0);
    for (int ch = 0; ch < nch; ++ch) {
        float cl[4][2];
        { float r0 = 0.f, r1 = 0.f;
#pragma unroll
          for (int ii = 0; ii < 4; ++ii) { const f32x2 gg = unpk_f16(g2[ii]); r0 += gg.x; r1 += gg.y; cl[ii][0] = r0; cl[ii][1] = r1; }
          *(LAS f32x2*)(L + SC_TOT + (w * 128 + 2 * lane) * 4) = (f32x2){r0, r1}; }
        __syncthreads();
        float pre[2] = {0.f, 0.f}, b15[2] = {0.f, 0.f}, b31[2] = {0.f, 0.f};
#pragma unroll
        for (int ww = 0; ww < 8; ++ww) { const f32x2 t = *(const LAS f32x2*)(L + SC_TOT + (ww * 128 + 2 * lane) * 4);
            if (ww < w) { pre[0] += t.x; pre[1] += t.y; } if (ww < 4) { b15[0] += t.x; b15[1] += t.y; } b31[0] += t.x; b31[1] += t.y; }
        const bool blk1 = w >= 4;
        {
            float kt[2][4];
#pragma unroll
            for (int ii = 0; ii < 4; ++ii) {
                const int i = 4 * w + ii;
                const float qv[2] = {bf_lo(q2[ii]), bf_hi(q2[ii])}, kv[2] = {bf_lo(k2[ii]), bf_hi(k2[ii])};
                float qt[2], qh[2], kh[2], ko[2];
#pragma unroll
                for (int x = 0; x < 2; ++x) {
                    const float b = pre[x] + cl[ii][x];
                    const float bref = blk1 ? b15[x] : 0.f;
                    qt[x] = qv[x] * fast_exp2(b);
                    qh[x] = qv[x] * fast_exp2(b - bref);
                    kh[x] = kv[x] * fast_exp2(fminf(bref - b, 80.f));
                    ko[x] = kv[x] * fast_exp2(b15[x] - b);
                    kt[x][ii] = kv[x] * fast_exp2(b31[x] - b);
                }
                *(LAS unsigned*)(L + SC_QT + i * 272 + 4 * lane) = pk_bf16(qt[0], qt[1]);
                *(LAS unsigned*)(L + SC_KH + i * 272 + 4 * lane) = pk_bf16(kh[0], kh[1]);
                if (blk1) *(LAS unsigned*)(L + SC_QH + (i - 16) * 272 + 4 * lane) = pk_bf16(qh[0], qh[1]);
                else      *(LAS unsigned*)(L + SC_KO + i * 272 + 4 * lane) = pk_bf16(ko[0], ko[1]);
            }
#pragma unroll
            for (int x = 0; x < 2; ++x) { u32x2 v; v.x = pk_bf16(kt[x][0], kt[x][1]); v.y = pk_bf16(kt[x][2], kt[x][3]); *(LAS u32x2*)(L + SC_KT + (2 * lane + x) * 80 + 8 * w) = v; }
            { u32x2 v0, v1; v0.x = (v2[0] & 0xffffu) | (v2[1] << 16); v0.y = (v2[2] & 0xffffu) | (v2[3] << 16); v1.x = (v2[0] >> 16) | (v2[1] & 0xffff0000u); v1.y = (v2[2] >> 16) | (v2[3] & 0xffff0000u);
              *(LAS u32x2*)(L + SC_VT + (2 * lane) * 80 + 8 * w) = v0; *(LAS u32x2*)(L + SC_VT + (2 * lane + 1) * 80 + 8 * w) = v1; }
            if (w == 0) *(LAS f32x2*)(L + SC_DEC + 8 * lane) = (f32x2){fast_exp2(b31[0]), fast_exp2(b31[1])};
        }
        __syncthreads();
        if (ch + 1 < nch) SCAN_LOAD(ch + 1);
        f32x4 ao[2] = {(f32x4){0.f, 0.f, 0.f, 0.f}, (f32x4){0.f, 0.f, 0.f, 0.f}};
#pragma unroll
        for (int ks = 0; ks < 4; ++ks) {
            const bf16x8 sb = *(const LAS bf16x8*)(L + SC_SL + (16 * w + c) * 272 + (32 * ks + 8 * g) * 2);
#pragma unroll
            for (int it = 0; it < 2; ++it) { const bf16x8 a = *(const LAS bf16x8*)(L + SC_QT + (16 * it + c) * 272 + (32 * ks + 8 * g) * 2); ao[it] = __builtin_amdgcn_mfma_f32_16x16x32_bf16(a, sb, ao[it], 0, 0, 0); }
        }
        if (w < 3) {
            const int abase = w == 0 ? SC_QT : SC_QH, bbase = w == 0 ? SC_KH : (w == 1 ? SC_KO : SC_KH + 16 * 272);
            f32x4 sc = {0.f, 0.f, 0.f, 0.f};
#pragma unroll
            for (int ks = 0; ks < 4; ++ks) { const bf16x8 a = *(const LAS bf16x8*)(L + abase + c * 272 + (32 * ks + 8 * g) * 2), b = *(const LAS bf16x8*)(L + bbase + c * 272 + (32 * ks + 8 * g) * 2);
                sc = __builtin_amdgcn_mfma_f32_16x16x32_bf16(a, b, sc, 0, 0, 0); }
            const int I = w >= 1, J = w == 2;
#pragma unroll
            for (int r = 0; r < 4; ++r) { float v = sc[r]; if (w != 1 && c > 4 * g + r) v = 0.f; *(LAS bf16_t*)(L + SC_SC + (16 * I + 4 * g + r) * 80 + (16 * J + c) * 2) = to_bf16(v); }
        }
        const bf16x8 vb = *(const LAS bf16x8*)(L + SC_VT + (16 * w + c) * 80 + 16 * g);
#pragma unroll
        for (int a = 0; a < 8; ++a) {
            const f32x4 dc = *(const LAS f32x4*)(L + SC_DEC + (16 * a + 4 * g) * 4);
            const bf16x8 ka = *(const LAS bf16x8*)(L + SC_KT + (16 * a + c) * 80 + 16 * g);
            S[a] = __builtin_amdgcn_mfma_f32_16x16x32_bf16(ka, vb, S[a] * dc, 0, 0, 0);
            u32x2 v; v.x = pk_bf16(S[a][0], S[a][1]); v.y = pk_bf16(S[a][2], S[a][3]); *(LAS u32x2*)(L + SC_SL + (16 * w + c) * 272 + (16 * a + 4 * g) * 2) = v;
        }
        __syncthreads();
#pragma unroll
        for (int it = 0; it < 2; ++it) { const bf16x8 a = *(const LAS bf16x8*)(L + SC_SC + (16 * it + c) * 80 + 16 * g); ao[it] = __builtin_amdgcn_mfma_f32_16x16x32_bf16(a, vb, ao[it], 0, 0, 0); }
#pragma unroll
        for (int it = 0; it < 2; ++it)
#pragma unroll
            for (int r = 0; r < 4; ++r) { const int il = 32 * ch + 16 * it + 4 * g + r; const int tok = dir ? (T - 1 - il) : il; Kp[(size_t)(rowbase + tok) * DM + h * 128 + 16 * w + c] = to_bf16(ao[it][r]); }
    }
#undef SCAN_LOAD
    if (sfin) {
#pragma unroll
        for (int a = 0; a < 8; ++a)
#pragma unroll
            for (int r = 0; r < 4; ++r) sfin[(size_t)(16 * a + 4 * g + r) * 128 + 16 * w + c] = S[a][r];
    }
    __syncthreads();
}
__device__ __forceinline__ void scan_phase(Frame& F, const ScanP& P) {
    if (F.bid < 64) {
        const int b = F.bid >> 4, h = (F.bid >> 1) & 7, dir = F.bid & 1;
        scan_item(F, P, M_CTX + b * 2048, 2048, h, dir, P.s_in + ((size_t)((b * 2 + P.j) * 2 + dir) * 8 + h) * 16384, nullptr);
    } else {
        const int nw = F.G - 64;
        for (int it = F.bid - 64; it < 512; it += nw) {
            const int b = it >> 4, h = (it >> 1) & 7, dir = it & 1;
            scan_item(F, P, b * 256, 256, h, dir, nullptr, P.s_out + ((size_t)((b * 2 + P.j) * 2 + dir) * 8 + h) * 16384);
        }
    }
}
__device__ __forceinline__ void combine_phase(Frame& F, const bf16_t* OF, const bf16_t* OB, bf16_t* A2, const float* gn) {
    const int gw = F.bid * NWAVES + F.wave, NGW = F.G * NWAVES;
    const int ch = 16 * F.lane;
    float gv[16];
#pragma unroll
    for (int e = 0; e < 16; e += 4) { const f32x4 t = *(const f32x4*)(gn + ch + e); gv[e] = t[0]; gv[e + 1] = t[1]; gv[e + 2] = t[2]; gv[e + 3] = t[3]; }
    for (int row = gw; row < M_TOT; row += NGW) {
        const size_t o = (size_t)row * DM + ch;
        const u32x4 f0 = *(const u32x4*)(OF + o), f1 = *(const u32x4*)(OF + o + 8), b0 = *(const u32x4*)(OB + o), b1 = *(const u32x4*)(OB + o + 8);
        const u32x4 s0 = *(const u32x4*)(A2 + o), s1 = *(const u32x4*)(A2 + o + 8);
        float v[16]; float sq = 0.f;
#pragma unroll
        for (int e = 0; e < 4; ++e) { v[2 * e] = bf_lo(f0[e]) + bf_lo(b0[e]); v[2 * e + 1] = bf_hi(f0[e]) + bf_hi(b0[e]); v[8 + 2 * e] = bf_lo(f1[e]) + bf_lo(b1[e]); v[8 + 2 * e + 1] = bf_hi(f1[e]) + bf_hi(b1[e]); }
#pragma unroll
        for (int e = 0; e < 16; ++e) sq += v[e] * v[e];
        sq += __shfl_xor(sq, 1); sq += __shfl_xor(sq, 2); sq += __shfl_xor(sq, 4);
        const float rs = rsqrtf(sq * (1.f / 128.f) + EPS);
        u32x4 w0, w1;
#pragma unroll
        for (int e = 0; e < 4; ++e) {
            w0[e] = pk_bf16(v[2 * e] * rs * gv[2 * e] * bf_lo(s0[e]), v[2 * e + 1] * rs * gv[2 * e + 1] * bf_hi(s0[e]));
            w1[e] = pk_bf16(v[8 + 2 * e] * rs * gv[8 + 2 * e] * bf_lo(s1[e]), v[8 + 2 * e + 1] * rs * gv[8 + 2 * e + 1] * bf_hi(s1[e]));
        }
        *(u32x4*)(A2 + o) = w0; *(u32x4*)(A2 + o + 8) = w1;
    }
}

constexpr int AT_K = 0, AT_KSZ = 32 * 272, AT_V = 2 * AT_KSZ, AT_VSZ = 128 * 72, AT_END = AT_V + 2 * AT_VSZ;
static_assert(AT_END <= 131072, "attn lds");
struct AttnP { const bf16_t* Qa; const bf16_t* Ka; const bf16_t* VaT; const bf16_t* CK; const bf16_t* CVT; bf16_t* O; const float* sink; int j; };
__device__ __forceinline__ int crow(int r, int hi) { return (r & 3) + 8 * (r >> 2) + 4 * hi; }

__device__ __forceinline__ void attn_unit(Frame& F, const AttnP& P, int qrow0, int head, float sink_t,
                                          const bf16_t* K0, int kst0, const bf16_t* V0, int vst0, int n0,
                                          const bf16_t* K1, int kst1, const bf16_t* V1, int vst1, int n1, int tok0_1, int tq0) {
    const lptr L = F.lds; const int tid = F.tid, lane = F.lane, w = F.wave, r32 = lane & 31, hi = lane >> 5;
    bf16x8 qf[8];
    { const bf16_t* qp = P.Qa + (size_t)(qrow0 + 32 * w + r32) * DM + head * 128 + 8 * hi;
#pragma unroll
      for (int ks = 0; ks < 8; ++ks) qf[ks] = *(const bf16x8*)(qp + 16 * ks); }
    f32x16 o[4];
#pragma unroll
    for (int d = 0; d < 4; ++d)
#pragma unroll
        for (int r = 0; r < 16; ++r) o[d][r] = 0.f;
    float mrun = sink_t, lrun = hi == 0 ? 1.f : 0.f;
    const int ntile = (n0 + n1) >> 5, nt0 = n0 >> 5;
    const int tq = tq0 + 32 * w + r32;
    const int skey = tid >> 4, sch = tid & 15, sd = tid >> 2, svc = tid & 3;
    u32x4 kreg, vreg;
#define AT_LOAD(t) do { const int t_ = (t); if (t_ < nt0) { kreg = *(const u32x4*)(K0 + (size_t)(32 * t_ + skey) * kst0 + 8 * sch); vreg = *(const u32x4*)(V0 + (size_t)sd * vst0 + 32 * t_ + 8 * svc); } \
        else { const int u_ = t_ - nt0; kreg = *(const u32x4*)(K1 + (size_t)(32 * u_ + skey) * kst1 + 8 * sch); vreg = *(const u32x4*)(V1 + (size_t)sd * vst1 + 32 * u_ + 8 * svc); } } while (0)
#define AT_STORE(buf) do { *(LAS u32x4*)(L + AT_K + (buf) * AT_KSZ + skey * 272 + 16 * sch) = kreg; \
        *(LAS u32x2*)(L + AT_V + (buf) * AT_VSZ + sd * 72 + 16 * svc) = (u32x2){vreg.x, vreg.y}; *(LAS u32x2*)(L + AT_V + (buf) * AT_VSZ + sd * 72 + 16 * svc + 8) = (u32x2){vreg.z, vreg.w}; } while (0)
    AT_LOAD(0); AT_STORE(0);
    if (ntile > 1) AT_LOAD(1);
    __syncthreads();
    for (int t = 0; t < ntile; ++t) {
        const int buf = t & 1;
        if (t + 1 < ntile) { AT_STORE(buf ^ 1); if (t + 2 < ntile) AT_LOAD(t + 2); }
        bool active = true; int kt0 = 0;
        if (t >= nt0) { kt0 = tok0_1 + 32 * (t - nt0); const int tw = tq0 + 32 * w; active = (kt0 + 31 >= tw - 128) && (kt0 <= tw + 31 + 128); }
        if (active) {
            f32x16 s;
#pragma unroll
            for (int r = 0; r < 16; ++r) s[r] = 0.f;
            const lptr kb = L + AT_K + buf * AT_KSZ + r32 * 272 + 16 * hi;
#pragma unroll
            for (int ks = 0; ks < 8; ++ks) { const bf16x8 kf = *(const LAS bf16x8*)(kb + 32 * ks); s = __builtin_amdgcn_mfma_f32_32x32x16_bf16(kf, qf[ks], s, 0, 0, 0); }
            if (t >= nt0) {
#pragma unroll
                for (int r = 0; r < 16; ++r) { const int dk = kt0 + crow(r, hi) - tq; if (dk > 128 || dk < -128) s[r] = -INFINITY; }
            }
            float tm = s[0];
#pragma unroll
            for (int r = 1; r < 16; ++r) tm = fmaxf(tm, s[r]);
            tm = fmaxf(tm, __shfl_xor(tm, 32));
            const float mn = fmaxf(mrun, tm), alpha = fast_exp2(mrun - mn);
            mrun = mn;
            float ps = 0.f;
#pragma unroll
            for (int r = 0; r < 16; ++r) { s[r] = fast_exp2(s[r] - mn); ps += s[r]; }
            lrun = lrun * alpha + ps;
#pragma unroll
            for (int d = 0; d < 4; ++d)
#pragma unroll
                for (int r = 0; r < 16; ++r) o[d][r] *= alpha;
            bf16x8 pf[2];
#pragma unroll
            for (int kk = 0; kk < 2; ++kk) { u32x4 pw; pw.x = pk_bf16(s[8 * kk + 0], s[8 * kk + 1]); pw.y = pk_bf16(s[8 * kk + 2], s[8 * kk + 3]); pw.z = pk_bf16(s[8 * kk + 4], s[8 * kk + 5]); pw.w = pk_bf16(s[8 * kk + 6], s[8 * kk + 7]); pf[kk] = __builtin_bit_cast(bf16x8, pw); }
            const lptr vbp = L + AT_V + buf * AT_VSZ + r32 * 72 + 8 * hi;
#pragma unroll
            for (int d = 0; d < 4; ++d)
#pragma unroll
                for (int kk = 0; kk < 2; ++kk) {
                    const u32x2 lo = *(const LAS u32x2*)(vbp + d * 32 * 72 + 32 * kk), hh = *(const LAS u32x2*)(vbp + d * 32 * 72 + 32 * kk + 16);
                    const u32x4 vv = {lo.x, lo.y, hh.x, hh.y};
                    o[d] = __builtin_amdgcn_mfma_f32_32x32x16_bf16(__builtin_bit_cast(bf16x8, vv), pf[kk], o[d], 0, 0, 0);
                }
        }
        __syncthreads();
    }
#undef AT_LOAD
#undef AT_STORE
    const float lt = lrun + __shfl_xor(lrun, 32);
    const float inv = fast_rcp(lt);
    bf16_t* op = P.O + (size_t)(qrow0 + 32 * w + r32) * DM + head * 128 + 4 * hi;
#pragma unroll
    for (int d = 0; d < 4; ++d)
#pragma unroll
        for (int u = 0; u < 4; ++u) { u32x2 v; v.x = pk_bf16(o[d][4 * u] * inv, o[d][4 * u + 1] * inv); v.y = pk_bf16(o[d][4 * u + 2] * inv, o[d][4 * u + 3] * inv); *(u32x2*)(op + 32 * d + 8 * u) = v; }
}
__device__ __forceinline__ void attn_phase(Frame& F, const AttnP& P) {
    for (int u = F.bid; u < 256; u += F.G) {
        { const int b = u >> 3, head = u & 7, kvh = head >> 2;
          attn_unit(F, P, b * 256, head, P.sink[P.j * 8 + head] * LOG2E,
                    P.Ka + (size_t)(b * 256) * 256 + kvh * 128, 256, P.VaT + (size_t)(b * 2 + kvh) * 128 * 256, 256, 256,
                    nullptr, 0, nullptr, 0, 0, 0, 0); }
        { const int b = u >> 6, head = (u >> 3) & 7, qb = u & 7, kvh = head >> 2;
          const int lo = qb * 256 - 128 < 0 ? 0 : qb * 256 - 128, hi = qb * 256 + 384 > 2048 ? 2048 : qb * 256 + 384;
          attn_unit(F, P, M_CTX + b * 2048 + qb * 256, head, P.sink[P.j * 8 + head] * LOG2E,
                    P.CK + ((size_t)(b * 2 + P.j) * 512) * 256 + kvh * 128, 256, P.CVT + (size_t)((b * 2 + P.j) * 2 + kvh) * 128 * 512, 512, 512,
                    P.Ka + (size_t)(M_CTX + b * 2048 + lo) * 256 + kvh * 128, 256, P.VaT + (size_t)2097152 + (size_t)(b * 2 + kvh) * 128 * 2048 + lo, 2048, hi - lo, lo, qb * 256); }
    }
}

__device__ __forceinline__ void final_phase(Frame& F) {
    const int gw = F.bid * NWAVES + F.wave, NGW = F.G * NWAVES;
    const float* ss = (const float*)(F.ws + WS_SS) + (size_t)8 * M_TOT;
    for (int row = gw; row < M_TOT; row += NGW) {
        const float rstd = rsqrtf(ss[row] * (1.f / DM) + EPS);
        float* xr = F.out + (size_t)row * DM;
#pragma unroll
        for (int jx = 0; jx < 4; ++jx) { const int k = 4 * F.lane + 256 * jx; const f32x4 v = *(const f32x4*)(xr + k), n = *(const f32x4*)(F.in[11] + k); *(f32x4*)(xr + k) = v * rstd * n; }
    }
}

constexpr int LDS_BYTES = 147456, MISC_OFF = 131072 + 320;
constexpr int NPHASE = 25;
#ifndef KMASK
#define KMASK 0x7ff
#endif
#define KON(k) (((KMASK) >> (k)) & 1)

template <int PH>
__device__ __forceinline__ void run_phase(Frame& F) {
    asm volatile("" : "+s"(F.ws), "+s"(F.out), "+s"(F.in));
    asm volatile("" : "+s"(F.wave));
    F.lane = __builtin_amdgcn_mbcnt_hi(~0u, __builtin_amdgcn_mbcnt_lo(~0u, 0u)); asm volatile("" : "+v"(F.lane)); F.tid = F.wave * 64 + F.lane;
    unsigned char* ws = F.ws;
    if constexpr (PH == 0) { if (KON(0)) phase0a(F); }
    else if constexpr (PH == 1) { if (KON(1)) phase0b(F); }
    else if constexpr (PH == 24) { if (KON(2)) final_phase(F); }
    else {
        constexpr int p = PH - 2;
        constexpr int l = p < 6 ? 0 : (p < 11 ? 1 : (p < 17 ? 2 : 3));
        constexpr int sub = p < 6 ? p : (p < 11 ? p - 6 : (p < 17 ? p - 11 : p - 17));
        constexpr bool hg = (l & 1) == 0; constexpr int j = l >> 1;
        constexpr int s_mix = hg ? 3 : 2, s_gu = s_mix + 1, s_dn = s_mix + 2;
        pg8::StaticOrder S;
        if constexpr (sub == 0 && hg) { if (KON(3)) {
            pg8::Gemm g{(const bf16_t*)(ws + WS_XA), (const bf16_t*)(ws + WS_W_IN) + (size_t)j * A_IN * DM, M_TOT, A_IN, DM}; S.init(M_TOT, A_IN, F.G, F.bid);
            EpiIn E{ws, l};
            pg8::gemm_phase(F.lds, F.tid, g, S, E);
        } } else if constexpr (sub == 1 && hg) { if (KON(4)) {
            ScanP P{(const bf16_t*)(ws + WS_HQ), (const bf16_t*)(ws + WS_HV), (bf16_t*)(ws + WS_HKF), (bf16_t*)(ws + WS_HKB), (const unsigned short*)(ws + WS_HGF), (const unsigned short*)(ws + WS_HGB),
                    F.in[4], F.out + OUT_ST, j};
            scan_phase(F, P);
        } } else if constexpr (sub == 2 && hg) { if (KON(5)) {
            combine_phase(F, (const bf16_t*)(ws + WS_HKF), (const bf16_t*)(ws + WS_HKB), (bf16_t*)(ws + WS_A2), F.in[16] + (size_t)j * DM);
        } } else if constexpr (sub == 0 && !hg) { if (KON(6)) {
            pg8::Gemm g{(const bf16_t*)(ws + WS_XA), (const bf16_t*)(ws + WS_W_QKV) + (size_t)j * QKV_N * DM, M_TOT, QKV_N, DM}; S.init(M_TOT, QKV_N, F.G, F.bid);
            EpiQkv E{ws, F.out, l};
            pg8::gemm_phase(F.lds, F.tid, g, S, E);
        } } else if constexpr (sub == 1 && !hg) { if (KON(7)) {
            AttnP P{(const bf16_t*)(ws + WS_AQ), (const bf16_t*)(ws + WS_AK), (const bf16_t*)(ws + WS_AVT), (const bf16_t*)(ws + WS_CK), (const bf16_t*)(ws + WS_CVT), (bf16_t*)(ws + WS_A2), F.in[20], j};
            attn_phase(F, P);
        } } else if constexpr (sub == s_mix) { if (KON(8)) {
            const bf16_t* wt = hg ? (const bf16_t*)(ws + WS_W_OUTA) + (size_t)j * DM * DM : (const bf16_t*)(ws + WS_W_OUTB) + (size_t)j * DM * DM;
            pg8::Gemm g{(const bf16_t*)(ws + WS_A2), wt, M_TOT, DM, DM}; S.init(M_TOT, DM, F.G, F.bid);
            EpiRes E{ws, F.out, F.in, l, 0};
            pg8::gemm_phase(F.lds, F.tid, g, S, E);
        } } else if constexpr (sub == s_gu) { if (KON(9)) {
            pg8::Gemm g{(const bf16_t*)(ws + WS_XA), (const bf16_t*)(ws + WS_W_GU) + (size_t)l * GU_N * DM, M_TOT, GU_N, DM}; S.init(M_TOT, GU_N, F.G, F.bid);
            EpiGU E{ws, l};
            pg8::gemm_phase(F.lds, F.tid, g, S, E);
        } } else if constexpr (sub == s_dn) { if (KON(10)) {
            pg8::Gemm g{(const bf16_t*)(ws + WS_H), (const bf16_t*)(ws + WS_W_DN) + (size_t)l * DM * D_FF, M_TOT, DM, D_FF}; S.init(M_TOT, DM, F.G, F.bid);
            EpiRes E{ws, F.out, F.in, l, 1};
            pg8::gemm_phase(F.lds, F.tid, g, S, E);
        } }
    }
}

__global__ void __launch_bounds__(NTHREADS, 2) mk_fwd(Args args) {
    extern __shared__ __attribute__((aligned(16))) unsigned char lds_raw[];
    cg::grid_group grid = cg::this_grid();
    Frame F; F.lds = (lptr)lds_raw; F.tid = threadIdx.x; F.lane = F.tid & 63; F.wave = __builtin_amdgcn_readfirstlane(F.tid >> 6); F.G = gridDim.x; F.bid = blockIdx.x;
    F.in = (inptr_t)__builtin_amdgcn_kernarg_segment_ptr(); F.out = args.out; F.ws = args.ws;
    volatile LAS unsigned* MISC = (volatile LAS unsigned*)(F.lds + MISC_OFF);
    if (F.tid < 32) MISC[F.tid] = 0u;
    __syncthreads();
    XcdBarrier bar = xcd_barrier_post((unsigned*)(F.ws + WS_CTL) + 4096, MISC + 8);
    bool first_seam = true;
    const int lo = args.ph_lo, hi = args.ph_hi;
#define RUN(PH) if (lo <= (PH) && (PH) < hi) { run_phase<PH>(F); \
        if ((PH) + 1 < hi) { if (first_seam) { grid.sync(); first_seam = false; } else { bar.bar = (unsigned*)(F.ws + WS_CTL) + 4096; xcd_barrier(bar); } } }
    RUN(0) RUN(1) RUN(2) RUN(3) RUN(4) RUN(5) RUN(6) RUN(7) RUN(8) RUN(9) RUN(10) RUN(11) RUN(12)
    RUN(13) RUN(14) RUN(15) RUN(16) RUN(17) RUN(18) RUN(19) RUN(20) RUN(21) RUN(22) RUN(23) RUN(24)
#undef RUN
}

extern "C" void kernel_launch(void* const* d_in, const int* in_sizes, int n_in, void* d_out, int out_size, void* d_ws, size_t ws_size, hipStream_t stream) {
    static int grid = 0;
    if (grid == 0) {
        if (n_in != 21 || out_size != (int)OUT_TOTAL || ws_size < WS_END) { fprintf(stderr, "kernel_launch: unexpected shapes: n_in %d out %d ws %zu (need %zu)\n", n_in, out_size, ws_size, (size_t)WS_END); grid = -1; return; }
        int dev = 0, cus = 0, per_cu = 0;
        if (hipGetDevice(&dev) != hipSuccess || hipDeviceGetAttribute(&cus, hipDeviceAttributeMultiprocessorCount, dev) != hipSuccess) { grid = -1; return; }
        if (hipFuncSetAttribute((const void*)mk_fwd, hipFuncAttributeMaxDynamicSharedMemorySize, LDS_BYTES) != hipSuccess) { fprintf(stderr, "kernel_launch: hipFuncSetAttribute failed\n"); grid = -1; return; }
        if (hipOccupancyMaxActiveBlocksPerMultiprocessor(&per_cu, (const void*)mk_fwd, NTHREADS, LDS_BYTES) != hipSuccess || per_cu < 1) { fprintf(stderr, "kernel_launch: occupancy query %d\n", per_cu); (void)hipGetLastError(); grid = -1; return; }
        grid = cus;
    }
    if (grid < 0) return;
    if (hipMemsetAsync((char*)d_ws + WS_CTL, 0, WS_ZERO_BYTES, stream) != hipSuccess) return;
    Args a{};
    for (int i = 0; i < 21; ++i) a.in[i] = (const float*)d_in[i];
    a.out = (float*)d_out; a.ws = (unsigned char*)d_ws; a.ph_lo = 0; a.ph_hi = NPHASE;
    void* args[] = {&a};
    hipError_t e = hipLaunchCooperativeKernel((const void*)mk_fwd, dim3(grid), dim3(NTHREADS), args, LDS_BYTES, stream);
    if (e != hipSuccess) fprintf(stderr, "cooperative launch failed: %s (grid %d)\n", hipGetErrorString(e), grid);
}
```

```cpp
#include <hip/hip_runtime.h>
#include <hip/hip_cooperative_groups.h>
#include <cstdio>
#include <cstdint>
namespace cg = cooperative_groups;

#define LAS __attribute__((address_space(3)))
typedef unsigned short bf16_t;
typedef short bf16x8 __attribute__((ext_vector_type(8)));
typedef short s16x4 __attribute__((ext_vector_type(4)));
typedef float f32x4 __attribute__((ext_vector_type(4)));
typedef float f32x2 __attribute__((ext_vector_type(2)));
typedef float f32x16 __attribute__((ext_vector_type(16)));
typedef unsigned u32x4 __attribute__((ext_vector_type(4)));
typedef unsigned u32x2 __attribute__((ext_vector_type(2)));
typedef __bf16 bf16x2_t __attribute__((ext_vector_type(2)));
typedef _Float16 f16x2_t __attribute__((ext_vector_type(2)));
typedef LAS unsigned char* lptr;
#define GAS __attribute__((address_space(1)))
typedef const float* cfp_t;
struct inptr_t {
    __attribute__((address_space(4))) const cfp_t* p;
    __device__ __forceinline__ const float* operator[](int i) const { return (const float*)(const GAS float*)p[i]; }
};

constexpr int DM = 1024, M_CTX = 8192, M_TOT = 16384, NCOND = 5, DEPTH = 4;
constexpr int A_IN = 5120, QKV_N = 1536, D_FF = 2816, GU_N = 5632;
constexpr float EPS = 1e-6f;
constexpr float LOG2E = 1.4426950408889634f;
constexpr int NTHREADS = 512, NWAVES = 8;

constexpr size_t OUT_Y = 0, OUT_CK = 16777216, OUT_CV = 20971520, OUT_ST = 25165824, OUT_TOTAL = 41943040;

constexpr size_t MiB = 1u << 20;
constexpr size_t WS_CTL = 0;
constexpr size_t WS_MOD = 1 * MiB;
constexpr size_t WS_SS = WS_MOD + 512 * 1024;
constexpr size_t WS_ZERO_BYTES = 2 * MiB + 256 * 1024;
constexpr size_t WS_BIAS_IN = 3 * MiB;
constexpr size_t WS_BIAS_QKV = WS_BIAS_IN + 2 * 5 * 5120 * 4;
constexpr size_t WS_BIAS_GU = WS_BIAS_QKV + 2 * 5 * 1536 * 4;
constexpr size_t WS_LB = WS_BIAS_GU + 4 * 5 * 5632 * 4;
constexpr size_t WS_ROPE = WS_LB + 4 * 1024 * 4;
constexpr size_t WS_TAB_END = WS_ROPE + 2 * 2 * 64 * 32 * 4;
static_assert(WS_TAB_END <= 4 * MiB, "tables");
constexpr size_t WS_W_IN = 4 * MiB;
constexpr size_t WS_W_OUTA = WS_W_IN + (size_t)2 * 5120 * 1024 * 2;
constexpr size_t WS_W_QKV = WS_W_OUTA + (size_t)2 * 1024 * 1024 * 2;
constexpr size_t WS_W_OUTB = WS_W_QKV + (size_t)2 * 1536 * 1024 * 2;
constexpr size_t WS_W_GU = WS_W_OUTB + (size_t)2 * 1024 * 1024 * 2;
constexpr size_t WS_W_DN = WS_W_GU + (size_t)4 * 5632 * 1024 * 2;
constexpr size_t WS_CK = WS_W_DN + (size_t)4 * 1024 * 2816 * 2;
constexpr size_t WS_CVT = WS_CK + (size_t)4 * 2 * 512 * 256 * 2;
constexpr size_t WS_XA = WS_CVT + (size_t)4 * 2 * 512 * 256 * 2;
constexpr size_t WS_A2 = WS_XA + (size_t)M_TOT * DM * 2;
constexpr size_t WS_R = WS_A2 + (size_t)M_TOT * DM * 2;
constexpr size_t ACT = (size_t)M_TOT * DM * 2;
constexpr size_t WS_HQ = WS_R, WS_HKF = WS_R + ACT, WS_HKB = WS_R + 2 * ACT, WS_HV = WS_R + 3 * ACT, WS_HGF = WS_R + 4 * ACT, WS_HGB = WS_R + 5 * ACT;
constexpr size_t WS_H = WS_R;
constexpr size_t WS_AQ = WS_R, WS_AK = WS_R + ACT, WS_AVT = WS_AK + (size_t)M_TOT * 256 * 2;
constexpr size_t WS_OFW = WS_R + 6 * ACT;
constexpr size_t WS_XB = WS_OFW + ACT;
constexpr size_t WS_END = WS_XB + ACT;

__device__ __forceinline__ unsigned pk_bf16(float lo, float hi) { f32x2 v = {lo, hi}; bf16x2_t b = __builtin_convertvector(v, bf16x2_t); return __builtin_bit_cast(unsigned, b); }
__device__ __forceinline__ bf16_t to_bf16(float x) { return (bf16_t)(pk_bf16(x, 0.f) & 0xffffu); }
__device__ __forceinline__ float bf_lo(unsigned u) { return __uint_as_float(u << 16); }
__device__ __forceinline__ float bf_hi(unsigned u) { return __uint_as_float(u & 0xffff0000u); }
__device__ __forceinline__ unsigned pk_f16(float lo, float hi) { f32x2 v = {lo, hi}; f16x2_t h = __builtin_convertvector(v, f16x2_t); return __builtin_bit_cast(unsigned, h); }
__device__ __forceinline__ f32x2 unpk_f16(unsigned u) { f16x2_t h = __builtin_bit_cast(f16x2_t, u); return __builtin_convertvector(h, f32x2); }
__device__ __forceinline__ float fast_exp2(float x) { return __builtin_amdgcn_exp2f(x); }
__device__ __forceinline__ float fast_rcp(float x) { return __builtin_amdgcn_rcpf(x); }
__device__ __forceinline__ float silu_f(float z) { z = fminf(fmaxf(z, -60.f), 60.f); return z * fast_rcp(1.f + fast_exp2(-z * LOG2E)); }
__device__ __forceinline__ float wave_sum(float v) {
#pragma unroll
    for (int o = 1; o < 64; o <<= 1) v += __shfl_xor(v, o);
    return v;
}
typedef int i32x4 __attribute__((ext_vector_type(4)));
constexpr float MOD_SCALE = 16777216.f, MOD_INV = 1.f / 16777216.f;
constexpr float SS_SCALE = 4096.f, SS_INV = 1.f / 4096.f;
__device__ __forceinline__ f32x4 modv4(const int* p) { const i32x4 v = *(const i32x4*)p; return (f32x4){(float)v.x * MOD_INV, (float)v.y * MOD_INV, (float)v.z * MOD_INV, (float)v.w * MOD_INV}; }
__device__ __forceinline__ float ss_rstd(const unsigned* ss, int row) { return rsqrtf((float)ss[row] * (SS_INV / DM) + EPS); }
__device__ __forceinline__ int cond_of_tile(int pm) { return pm < 32 ? 0 : 1 + ((pm - 32) >> 3); }
__device__ __forceinline__ int cond_of_row(int row) { return row < M_CTX ? 0 : 1 + ((row - M_CTX) >> 11); }

#define XB_TMO      128
#define XB_XCNT(j)  (256  + 64 * (j))
#define XB_XSUB(j)  (1280 + 64 * (j))
#define XB_XGEN(j)  (2304 + 64 * (j))
#define XB_TOP      3328
#define XB_TOPGEN   3392
#define XCD_BAR_WORDS 3456
#define XB_SPIN_CAP (1u << 20)
__device__ __forceinline__ unsigned xb_ld(unsigned* p)              { return __hip_atomic_load(p, __ATOMIC_RELAXED, __HIP_MEMORY_SCOPE_AGENT); }
__device__ __forceinline__ unsigned xb_add(unsigned* p, unsigned v) { return __hip_atomic_fetch_add(p, v, __ATOMIC_RELAXED, __HIP_MEMORY_SCOPE_AGENT); }
__device__ __forceinline__ unsigned xb_xcc_id() { return (unsigned)__builtin_amdgcn_s_getreg((3 << 11) | 20) & 0xFu; }
#define XB_SPIN(cond, bar) do { unsigned _sp = 0; while (cond) { __builtin_amdgcn_s_sleep(1); \
    if ((++_sp & 255u) == 0u) { if (xb_ld(&(bar)[XB_TMO])) break; if (_sp > XB_SPIN_CAP) { atomicAdd(&(bar)[XB_TMO], 1u); break; } } } } while (0)
struct XcdBarrier { unsigned* bar; unsigned x; volatile LAS unsigned* st; };
__device__ __forceinline__ XcdBarrier xcd_barrier_post(unsigned* bar, volatile LAS unsigned* st) {
    XcdBarrier b; b.bar = bar; b.x = xb_xcc_id(); b.st = st;
    if (threadIdx.x == 0) (void)xb_add(&bar[XB_XCNT(b.x)], 1u);
    return b;
}
__device__ __forceinline__ void xcd_barrier_complete(unsigned* bar, unsigned x, unsigned& nloc, unsigned& nx) {
    const unsigned G = gridDim.x * gridDim.y * gridDim.z;
    unsigned sum, cnt, mine, sp = 0u;
    for (;;) {
        sum = 0u; cnt = 0u; mine = 0u;
#pragma unroll
        for (unsigned j = 0; j < 16; ++j) { const unsigned c = xb_ld(&bar[XB_XCNT(j)]); sum += c; cnt += (c > 0u) ? 1u : 0u; mine = (j == x) ? c : mine; }
        if (sum == G) break;
        __builtin_amdgcn_s_sleep(1);
        if ((++sp & 255u) == 0u) { if (xb_ld(&bar[XB_TMO])) break; if (sp > XB_SPIN_CAP) { atomicAdd(&bar[XB_TMO], 1u); break; } }
    }
    nloc = mine > 0u ? mine : 1u; nx = cnt > 0u ? cnt : 1u;
}
__device__ __forceinline__ void xcd_barrier(const XcdBarrier& b) {
    asm volatile("s_waitcnt vmcnt(0)" ::: "memory");
    __syncthreads();
    if (threadIdx.x == 0) {
        unsigned* bar = b.bar;
        __builtin_amdgcn_s_waitcnt(0);
        unsigned nloc = b.st[0], nx = b.st[1];
        if (nloc == 0u) { xcd_barrier_complete(bar, b.x, nloc, nx); b.st[0] = nloc; b.st[1] = nx; }
        const unsigned old = xb_add(&bar[XB_XSUB(b.x)], 1u);
        const unsigned gen = old / nloc;
        if (old + 1u == (gen + 1u) * nloc) {
            __builtin_amdgcn_fence(__ATOMIC_RELEASE, "agent");
            asm volatile("s_waitcnt vmcnt(0)" ::: "memory");
            const unsigned og = xb_add(&bar[XB_TOP], 1u);
            const unsigned tg = og / nx;
            if (og + 1u == (tg + 1u) * nx) xb_add(&bar[XB_TOPGEN], 1u);
            else XB_SPIN(xb_ld(&bar[XB_TOPGEN]) == tg, bar);
            __builtin_amdgcn_fence(__ATOMIC_ACQUIRE, "agent");
            xb_add(&bar[XB_XGEN(b.x)], 1u);
            asm volatile("s_waitcnt vmcnt(0)" ::: "memory");
        } else {
            XB_SPIN(xb_ld(&bar[XB_XGEN(b.x)]) == gen, bar);
            __builtin_amdgcn_fence(__ATOMIC_ACQUIRE, "agent");
            asm volatile("s_waitcnt vmcnt(0)" ::: "memory");
        }
    }
    __syncthreads();
}

namespace pg8 {
constexpr int BM = 256, BK = 64, HALF = 128, HTB = HALF * BK * 2, STAGE_BYTES = 8 * HTB, NXCD = 8, WGM = 8;
__host__ __device__ __forceinline__ int lds_byte(int r, int c) { const int st = (r >> 4) * 2 + (c >> 5), rr = r & 15, cc = c & 31, ob = rr * 64 + cc * 2; return st * 1024 + (ob ^ (((ob >> 9) & 1) << 5)); }
__host__ __device__ __forceinline__ void stage_rc(int b, int& R, int& C) { const int st = b / 1024, sb = b % 1024, swz = sb ^ (((sb >> 9) & 1) << 5); R = (st >> 1) * 16 + swz / 64; C = (st & 1) * 32 + (swz % 64) / 2; }
__host__ __device__ __forceinline__ int perm32(int rho) { const int n = rho >> 4, i = rho & 15; return 8 * (i >> 2) + 4 * n + (i & 3); }
struct Unit { int pm, pn; };
struct Gemm { const bf16_t* A; const bf16_t* Bt; int M, N, K; };
struct StaticOrder {
    int nM, nN, nwg, G, c;
    __host__ __device__ void init(int M, int N, int G_, int c_) { nM = M / BM; nN = N / BM; nwg = nM * nN; G = G_; c = c_; }
    __host__ __device__ bool next(int i, Unit& u) const {
        const long L = (long)i * G + c; if (L >= nwg) return false;
        int wgid = (int)L; { const int q = nwg / NXCD, r = nwg % NXCD, xcd = wgid % NXCD, off = wgid / NXCD; wgid = (xcd < r ? xcd * (q + 1) : r * (q + 1) + (xcd - r) * q) + off; }
        const int nig = WGM * nN, gid = wgid / nig, fm = gid * WGM, gsz = (nM - fm) < WGM ? (nM - fm) : WGM;
        u.pm = fm + ((wgid % nig) % gsz); u.pn = (wgid % nig) / gsz; return true;
    }
};
template <class Epi>
__device__ __forceinline__ void gemm_phase(lptr lds, const int tid, const Gemm g, const StaticOrder& S, const Epi& E) {
    const int wid = __builtin_amdgcn_readfirstlane(tid >> 6), lane = tid & 63, wr = wid >> 2, wc = wid & 3, fr = lane & 15, fq = lane >> 4;
    const int K = g.K, nt = K / BK;
    unsigned voffA[2], voffB[2];
#pragma unroll
    for (int i = 0; i < 2; ++i) { int R, C; stage_rc(tid * 16 + i * 8192, R, C); const int Rb = (R & ~31) + perm32(R & 31);
        voffA[i] = (unsigned)(R * K + C) * 2u; voffB[i] = (unsigned)(Rb * K + C) * 2u; }
    const size_t kstep = (size_t)(BK * 2);
    const size_t hstep = (size_t)HALF * K * 2;
    const size_t tstep = 2 * hstep;
    const unsigned ldsw = (unsigned)wid * 1024u;
    const int aoff = lds_byte(wr * 64 + fr, fq * 8), boff = lds_byte(wc * 32 + fr, fq * 8);
#define PG8_SA(b, h) (((b) * 2 + (h)) * HTB)
#define PG8_SB(b, h) ((4 + (b) * 2 + (h)) * HTB)
#define PG8_STAGE(bufoff, gbase, voff) do { _Pragma("unroll") for (int _i = 0; _i < 2; ++_i) \
        __builtin_amdgcn_global_load_lds((const unsigned*)((const char*)(gbase) + (voff)[_i]), (LAS unsigned*)(lds + (bufoff) + ldsw + _i * 8192), 16, 0, 0); } while (0)
#define PG8_LDA(dst, b, h) do { _Pragma("unroll") for (int m = 0; m < 4; ++m) _Pragma("unroll") for (int k = 0; k < 2; ++k) dst[m][k] = *(const LAS bf16x8*)(lds + PG8_SA(b, h) + aoff + m * 2048 + k * 1024); } while (0)
#define PG8_LDB(dst, b, h) do { _Pragma("unroll") for (int n = 0; n < 2; ++n) _Pragma("unroll") for (int k = 0; k < 2; ++k) dst[n][k] = *(const LAS bf16x8*)(lds + PG8_SB(b, h) + boff + n * 2048 + k * 1024); } while (0)
#define PG8_MMA(ai, bj, At, Bt) do { __builtin_amdgcn_s_setprio(1); _Pragma("unroll") for (int m = 0; m < 4; ++m) _Pragma("unroll") for (int n = 0; n < 2; ++n) _Pragma("unroll") for (int k = 0; k < 2; ++k) \
        acc[ai][bj][m][n] = __builtin_amdgcn_mfma_f32_16x16x32_bf16(Bt[n][k], At[m][k], acc[ai][bj][m][n], 0, 0, 0); __builtin_amdgcn_s_setprio(0); } while (0)
#define PG8_WAIT_V(n) asm volatile("s_waitcnt vmcnt(" #n ")" ::: "memory")
#define PG8_WAIT_L(n) asm volatile("s_waitcnt lgkmcnt(" #n ")" ::: "memory")
#define PG8_BAR __builtin_amdgcn_s_barrier()
#define PG8_SCHED __builtin_amdgcn_sched_barrier(0)
    Unit cur, nxt; int ui = 0;
    if (!S.next(0, cur)) return;
    f32x4 acc[2][2][4][2];
#pragma unroll
    for (int a = 0; a < 2; ++a)
#pragma unroll
        for (int b = 0; b < 2; ++b)
#pragma unroll
            for (int m = 0; m < 4; ++m)
#pragma unroll
                for (int n = 0; n < 2; ++n) acc[a][b][m][n] = (f32x4){0.f, 0.f, 0.f, 0.f};
    bf16x8 At[4][2], B0[2][2], B1[2][2];
    const char* cA = (const char*)g.A + (size_t)cur.pm * tstep; const char* cB = (const char*)g.Bt + (size_t)cur.pn * tstep;
    PG8_STAGE(PG8_SB(0, 0), cB, voffB); PG8_STAGE(PG8_SB(0, 1), cB + hstep, voffB); PG8_STAGE(PG8_SA(0, 0), cA, voffA); PG8_STAGE(PG8_SA(0, 1), cA + hstep, voffA);
    if (wr == 1) PG8_BAR;
    PG8_WAIT_V(2); PG8_BAR;
    PG8_STAGE(PG8_SB(1, 0), cB + kstep, voffB); PG8_STAGE(PG8_SA(1, 0), cA + kstep, voffA); PG8_STAGE(PG8_SB(1, 1), cB + hstep + kstep, voffB);
    PG8_WAIT_V(6); PG8_BAR;
    for (;;) {
        const bool has_next = S.next(ui + 1, nxt);
        const char* nA = has_next ? (const char*)g.A + (size_t)nxt.pm * tstep : cA; const char* nB = has_next ? (const char*)g.Bt + (size_t)nxt.pn * tstep : cB;
        for (int t = 0; t < nt; t += 2) {
            const bool last = (t == nt - 2);
            const char* a1 = cA + (size_t)(t + 1) * kstep;
            const char* a2 = last ? nA : cA + (size_t)(t + 2) * kstep; const char* b2 = last ? nB : cB + (size_t)(t + 2) * kstep;
            const char* a3 = a2 + kstep; const char* b3 = b2 + kstep;
            PG8_LDB(B0, 0, 0); PG8_LDB(B1, 0, 1); PG8_SCHED; PG8_LDA(At, 0, 0); PG8_STAGE(PG8_SA(1, 1), a1 + hstep, voffA);
            PG8_WAIT_V(8); PG8_WAIT_L(0); PG8_BAR; PG8_MMA(0, 0, At, B0); PG8_MMA(0, 1, At, B1); PG8_BAR; PG8_SCHED;
            PG8_LDA(At, 0, 1); PG8_STAGE(PG8_SB(0, 0), b2, voffB); PG8_STAGE(PG8_SB(0, 1), b2 + hstep, voffB); PG8_STAGE(PG8_SA(0, 0), a2, voffA);
            PG8_WAIT_V(8); PG8_WAIT_L(0); PG8_BAR; PG8_MMA(1, 0, At, B0); PG8_MMA(1, 1, At, B1); PG8_BAR; PG8_SCHED;
            PG8_LDB(B0, 1, 0); PG8_LDB(B1, 1, 1); PG8_SCHED; PG8_LDA(At, 1, 0); PG8_STAGE(PG8_SA(0, 1), a2 + hstep, voffA);
            PG8_WAIT_V(8); PG8_WAIT_L(0); PG8_BAR; PG8_MMA(0, 0, At, B0); PG8_MMA(0, 1, At, B1); PG8_BAR; PG8_SCHED;
            PG8_LDA(At, 1, 1); PG8_STAGE(PG8_SB(1, 0), b3, voffB); PG8_STAGE(PG8_SB(1, 1), b3 + hstep, voffB); PG8_STAGE(PG8_SA(1, 0), a3, voffA);
            PG8_WAIT_V(8); PG8_WAIT_L(0); PG8_BAR; PG8_MMA(1, 0, At, B0); PG8_MMA(1, 1, At, B1); PG8_BAR; PG8_SCHED;
        }
        if (wr == 0) PG8_BAR;
        E(acc, cur, wr, wc, fr, fq);
        if (!has_next) break;
#pragma unroll
        for (int a = 0; a < 2; ++a)
#pragma unroll
            for (int b = 0; b < 2; ++b)
#pragma unroll
                for (int m = 0; m < 4; ++m)
#pragma unroll
                    for (int n = 0; n < 2; ++n) acc[a][b][m][n] = (f32x4){0.f, 0.f, 0.f, 0.f};
        cur = nxt; cA = nA; cB = nB; ++ui;
        if (wr == 1) PG8_BAR;
    }
    PG8_WAIT_V(0);
    PG8_BAR;
#undef PG8_SA
#undef PG8_SB
#undef PG8_STAGE
#undef PG8_LDA
#undef PG8_LDB
#undef PG8_MMA
#undef PG8_WAIT_V
#undef PG8_WAIT_L
#undef PG8_BAR
#undef PG8_SCHED
}
}
typedef f32x4 AccT[2][2][4][2];

struct EpiIn {
    unsigned char* ws; int l;
    __device__ __forceinline__ void operator()(const AccT& acc, const pg8::Unit& u, int wr, int wc, int fr, int fq) const {
        const int j = l >> 1;
        const unsigned* ss = (const unsigned*)(ws + WS_SS) + (size_t)(2 * l) * M_TOT; const float* bias = (const float*)(ws + WS_BIAS_IN) + (size_t)j * NCOND * A_IN; const float* lb = (const float*)(ws + WS_LB) + (size_t)j * 2048;
        bf16_t* Q = (bf16_t*)(ws + WS_HQ); bf16_t* KF = (bf16_t*)(ws + WS_HKF); bf16_t* KB = (bf16_t*)(ws + WS_HKB); bf16_t* V = (bf16_t*)(ws + WS_HV); bf16_t* SG = (bf16_t*)(ws + WS_A2);
        unsigned short* GF = (unsigned short*)(ws + WS_HGF); unsigned short* GB = (unsigned short*)(ws + WS_HGB);
        const int cond = cond_of_tile(u.pm), type = u.pn >> 2, chb = (u.pn & 3) * 256 + wc * 32 + 8 * fq;
        const float* bp = bias + (size_t)cond * A_IN + type * 1024;
        float rs[8]; f32x4 bv[2][2], lv[2][2];
#pragma unroll
        for (int i = 0; i < 8; ++i) rs[i] = ss_rstd(ss, u.pm * 256 + (i >> 2) * 128 + wr * 64 + (i & 3) * 16 + fr);
#pragma unroll
        for (int bj = 0; bj < 2; ++bj) { bv[bj][0] = *(const f32x4*)(bp + chb + bj * 128); bv[bj][1] = *(const f32x4*)(bp + chb + bj * 128 + 4);
            const float* lp = lb + ((type == 2) ? 1024 : 0) + chb + bj * 128; lv[bj][0] = *(const f32x4*)lp; lv[bj][1] = *(const f32x4*)(lp + 4); }
        asm volatile("" ::: "memory");
#pragma unroll
        for (int ai = 0; ai < 2; ++ai)
#pragma unroll
            for (int m = 0; m < 4; ++m) {
                const int row = u.pm * 256 + ai * 128 + wr * 64 + m * 16 + fr;
                const float rstd = rs[ai * 4 + m];
#pragma unroll
                for (int bj = 0; bj < 2; ++bj) {
                    const int ch = chb + bj * 128;
                    const f32x4 b0 = bv[bj][0], b1 = bv[bj][1];
                    float z[8];
#pragma unroll
                    for (int e = 0; e < 4; ++e) { z[e] = acc[ai][bj][m][0][e] * rstd + b0[e]; z[4 + e] = acc[ai][bj][m][1][e] * rstd + b1[e]; }
                    const size_t o = (size_t)row * DM + ch;
                    if (type == 0 || type == 4) {
                        u32x4 w; w.x = pk_bf16(silu_f(z[0]), silu_f(z[1])); w.y = pk_bf16(silu_f(z[2]), silu_f(z[3])); w.z = pk_bf16(silu_f(z[4]), silu_f(z[5])); w.w = pk_bf16(silu_f(z[6]), silu_f(z[7]));
                        *(u32x4*)((type == 0 ? Q : SG) + o) = w;
                    } else if (type == 3) {
                        u32x4 w; w.x = pk_bf16(z[0], z[1]); w.y = pk_bf16(z[2], z[3]); w.z = pk_bf16(z[4], z[5]); w.w = pk_bf16(z[6], z[7]);
                        *(u32x4*)(V + o) = w;
                    } else {
                        const f32x4 l0 = lv[bj][0], l1 = lv[bj][1];
                        float lg[8];
#pragma unroll
                        for (int e = 0; e < 8; ++e) {
                            const float lbv = e < 4 ? l0[e] : l1[e - 4];
                            const float zz = fminf(fmaxf(z[e], -40.f), 40.f);
                            const float sg = fast_rcp(1.f + fast_exp2(-zz * LOG2E));
                            lg[e] = __builtin_amdgcn_logf(lbv + (1.f - lbv) * sg);
                        }
                        u32x4 h; h.x = pk_f16(lg[0], lg[1]); h.y = pk_f16(lg[2], lg[3]); h.z = pk_f16(lg[4], lg[5]); h.w = pk_f16(lg[6], lg[7]);
                        *(u32x4*)((type == 1 ? GF : GB) + o) = h;
                    }
                }
            }
    }
};

struct EpiQkv {
    unsigned char* ws; float* out; int l;
    __device__ __forceinline__ void operator()(const AccT& acc, const pg8::Unit& u, int wr, int wc, int fr, int fq) const {
        const int j = l >> 1;
        const unsigned* ss = (const unsigned*)(ws + WS_SS) + (size_t)(2 * l) * M_TOT; const float* bias = (const float*)(ws + WS_BIAS_QKV) + (size_t)j * NCOND * QKV_N; const float* rope = (const float*)(ws + WS_ROPE);
        bf16_t* Qa = (bf16_t*)(ws + WS_AQ); bf16_t* Ka = (bf16_t*)(ws + WS_AK); bf16_t* VaT = (bf16_t*)(ws + WS_AVT); float* outK = out + OUT_CK; float* outV = out + OUT_CV;
        const int cond = cond_of_tile(u.pm);
        const bool lat = u.pm >= 32;
        const float* bp = bias + (size_t)cond * QKV_N + u.pn * 256;
        const float qscale = 0.08838834764831845f * LOG2E;
        float rs[8]; f32x4 bv[2][2];
#pragma unroll
        for (int i = 0; i < 8; ++i) rs[i] = ss_rstd(ss, u.pm * 256 + (i >> 2) * 128 + wr * 64 + (i & 3) * 16 + fr);
#pragma unroll
        for (int bj = 0; bj < 2; ++bj) { const int cl = bj * 128 + wc * 32 + 8 * fq; bv[bj][0] = *(const f32x4*)(bp + cl); bv[bj][1] = *(const f32x4*)(bp + cl + 4); }
        asm volatile("" ::: "memory");
#pragma unroll
        for (int ai = 0; ai < 2; ++ai)
#pragma unroll
            for (int m = 0; m < 4; ++m) {
                const int row = u.pm * 256 + ai * 128 + wr * 64 + m * 16 + fr;
                const float rstd = rs[ai * 4 + m];
                const int tl = (row - M_CTX) & 2047;
                f32x4 csv[2], snv[2];
                if (lat && u.pn < 5) {
#pragma unroll
                    for (int bj = 0; bj < 2; ++bj) { const int hl = (bj * 128 + wc * 32 + 8 * fq) & 127, ax = hl >> 6, j0 = (hl & 63) >> 1; const int pos = ax ? (tl & 63) : (tl >> 6);
                        const float* cp = rope + (ax * 64 + pos) * 32 + j0; csv[bj] = *(const f32x4*)cp; snv[bj] = *(const f32x4*)(cp + 2 * 64 * 32); }
                    asm volatile("" ::: "memory");
                }
#pragma unroll
                for (int bj = 0; bj < 2; ++bj) {
                    const int cl = bj * 128 + wc * 32 + 8 * fq;
                    const f32x4 b0 = bv[bj][0], b1 = bv[bj][1];
                    float z[8];
#pragma unroll
                    for (int e = 0; e < 4; ++e) { z[e] = acc[ai][bj][m][0][e] * rstd + b0[e]; z[4 + e] = acc[ai][bj][m][1][e] * rstd + b1[e]; }
                    if (u.pn < 5) {
                        const int hl = cl & 127, ax = hl >> 6, j0 = (hl & 63) >> 1;
                        if (u.pn == 4 && !lat) {
                            const int b = row >> 8, t = row & 255, kvh = cl >> 7;
                            float* op = outK + ((size_t)((b * 2 + j) * 256 + t) * 2 + kvh) * 128 + ax * 64 + j0;
                            *(f32x4*)op = (f32x4){z[0], z[2], z[4], z[6]};
                            *(f32x4*)(op + 32) = (f32x4){z[1], z[3], z[5], z[7]};
                        }
                        if (lat) {
                            const f32x4 cs = csv[bj], sn = snv[bj];
#pragma unroll
                            for (int e = 0; e < 4; ++e) { const float x1 = z[2 * e], x2 = z[2 * e + 1]; z[2 * e] = x1 * cs[e] - x2 * sn[e]; z[2 * e + 1] = x1 * sn[e] + x2 * cs[e]; }
                        }
                        if (u.pn < 4) {
#pragma unroll
                            for (int e = 0; e < 8; ++e) z[e] *= qscale;
                            u32x4 w; w.x = pk_bf16(z[0], z[1]); w.y = pk_bf16(z[2], z[3]); w.z = pk_bf16(z[4], z[5]); w.w = pk_bf16(z[6], z[7]);
                            *(u32x4*)(Qa + (size_t)row * DM + u.pn * 256 + cl) = w;
                        } else {
                            u32x4 w; w.x = pk_bf16(z[0], z[1]); w.y = pk_bf16(z[2], z[3]); w.z = pk_bf16(z[4], z[5]); w.w = pk_bf16(z[6], z[7]);
                            *(u32x4*)(Ka + (size_t)row * 256 + cl) = w;
                        }
                    } else {
                        const int kvh = cl >> 7, d0 = cl & 127;
                        size_t vb; int T;
                        if (!lat) { const int b = row >> 8, t = row & 255; T = 256; vb = ((size_t)(b * 2 + kvh) * 128 + d0) * 256 + t;
                            float* op = outV + ((size_t)((b * 2 + j) * 256 + t) * 2 + kvh) * 128 + d0;
                            *(f32x4*)op = (f32x4){z[0], z[1], z[2], z[3]}; *(f32x4*)(op + 4) = (f32x4){z[4], z[5], z[6], z[7]};
                        } else { const int b = (row - M_CTX) >> 11; T = 2048; vb = (size_t)2097152 + ((size_t)(b * 2 + kvh) * 128 + d0) * 2048 + tl; }
#pragma unroll
                        for (int e = 0; e < 8; ++e) VaT[vb + (size_t)e * T] = to_bf16(z[e]);
                    }
                }
            }
    }
};

struct EpiRes {
    unsigned char* ws; float* x; inptr_t in; int l; int down;
    __device__ __forceinline__ void operator()(const AccT& acc, const pg8::Unit& u, int wr, int wc, int fr, int fq) const {
        const int* mod = (const int*)(ws + WS_MOD);
        const bool lastl = down && l == 3;
        const int* gate = mod + (size_t)l * 6144 + (down ? 5120 : 2048);
        const float* nw = down ? in[9] + (size_t)(l + 1) * DM : in[10] + (size_t)l * DM;
        const int* sc = lastl ? nullptr : (down ? mod + (size_t)(l + 1) * 6144 + 1024 : mod + (size_t)l * 6144 + 4096);
        unsigned* ssout = (unsigned*)(ws + WS_SS) + (size_t)(2 * l + 1 + down) * M_TOT;
        bf16_t* XA = lastl ? nullptr : (bf16_t*)(ws + WS_XA);
        const int cond = cond_of_tile(u.pm);
        const int* gp = gate + (size_t)cond * (4 * 6144); const int* sp = sc ? sc + (size_t)cond * (4 * 6144) : nullptr;
        f32x4 gv[2][2], nsv[2][2];
#pragma unroll
        for (int bj = 0; bj < 2; ++bj) { const int col = u.pn * 256 + bj * 128 + wc * 32 + 8 * fq;
            gv[bj][0] = modv4(gp + col); gv[bj][1] = modv4(gp + col + 4);
            if (XA) { nsv[bj][0] = *(const f32x4*)(nw + col) * (modv4(sp + col) + 1.f); nsv[bj][1] = *(const f32x4*)(nw + col + 4) * (modv4(sp + col + 4) + 1.f); } }
#pragma unroll
        for (int ai = 0; ai < 2; ++ai) {
            u32x4 xw[4][2];
#pragma unroll
            for (int m = 0; m < 4; ++m) {
                if (!(l == 0 && !down) && (m & 1) == 0) {
#pragma unroll
                    for (int mm = m; mm < m + 2; ++mm)
#pragma unroll
                        for (int bj = 0; bj < 2; ++bj) { const int row2 = u.pm * 256 + ai * 128 + wr * 64 + mm * 16 + fr, col = u.pn * 256 + bj * 128 + wc * 32 + 8 * fq;
                            xw[mm][bj] = *(const u32x4*)((const bf16_t*)(ws + WS_XB) + (size_t)row2 * DM + col); }
                    asm volatile("" ::: "memory");
                }
                const int row = u.pm * 256 + ai * 128 + wr * 64 + m * 16 + fr;
                f32x4 xv[2][2];
                if (l == 0 && !down) {
#pragma unroll
                    for (int bj = 0; bj < 2; ++bj) { const int col = u.pn * 256 + bj * 128 + wc * 32 + 8 * fq; const float* xs = u.pm < 32 ? in[0] + (size_t)row * DM + col : in[1] + (size_t)(row - M_CTX) * DM + col;
                        xv[bj][0] = *(const f32x4*)xs; xv[bj][1] = *(const f32x4*)(xs + 4); }
                    asm volatile("" ::: "memory");
                } else {
#pragma unroll
                    for (int bj = 0; bj < 2; ++bj) { const u32x4 t = xw[m][bj]; xv[bj][0] = (f32x4){bf_lo(t.x), bf_hi(t.x), bf_lo(t.y), bf_hi(t.y)}; xv[bj][1] = (f32x4){bf_lo(t.z), bf_hi(t.z), bf_lo(t.w), bf_hi(t.w)}; }
                }
                float sq = 0.f;
#pragma unroll
                for (int bj = 0; bj < 2; ++bj) {
                    const int col = u.pn * 256 + bj * 128 + wc * 32 + 8 * fq;
                    bf16_t* xp = (bf16_t*)(ws + WS_XB) + (size_t)row * DM + col;
                    const f32x4 x0 = xv[bj][0] + gv[bj][0] * acc[ai][bj][m][0], x1 = xv[bj][1] + gv[bj][1] * acc[ai][bj][m][1];
                    { u32x4 t; t.x = pk_bf16(x0[0], x0[1]); t.y = pk_bf16(x0[2], x0[3]); t.z = pk_bf16(x1[0], x1[1]); t.w = pk_bf16(x1[2], x1[3]); *(u32x4*)xp = t; }
                    sq += (x0[0] * x0[0] + x0[1] * x0[1]) + (x0[2] * x0[2] + x0[3] * x0[3]) + (x1[0] * x1[0] + x1[1] * x1[1]) + (x1[2] * x1[2] + x1[3] * x1[3]);
                    if (XA) {
                        const f32x4 a0 = x0 * nsv[bj][0], a1 = x1 * nsv[bj][1];
                        u32x4 w; w.x = pk_bf16(a0[0], a0[1]); w.y = pk_bf16(a0[2], a0[3]); w.z = pk_bf16(a1[0], a1[1]); w.w = pk_bf16(a1[2], a1[3]);
                        *(u32x4*)(XA + (size_t)row * DM + col) = w;
                    }
                }
                sq += __shfl_xor(sq, 16); sq += __shfl_xor(sq, 32);
                if (fq == 0) atomicAdd(ssout + row, (unsigned)(sq * SS_SCALE + 0.5f));
            }
        }
    }
};

struct EpiGU {
    unsigned char* ws; int l;
    __device__ __forceinline__ void operator()(const AccT& acc, const pg8::Unit& u, int wr, int wc, int fr, int fq) const {
        const unsigned* ss = (const unsigned*)(ws + WS_SS) + (size_t)(2 * l + 1) * M_TOT; const float* bias = (const float*)(ws + WS_BIAS_GU) + (size_t)l * NCOND * GU_N; bf16_t* H = (bf16_t*)(ws + WS_H);
        const int cond = cond_of_tile(u.pm);
        const float* bp = bias + (size_t)cond * GU_N;
        float rs[8]; f32x4 bv[2][2];
#pragma unroll
        for (int i = 0; i < 8; ++i) rs[i] = ss_rstd(ss, u.pm * 256 + (i >> 2) * 128 + wr * 64 + (i & 3) * 16 + fr);
#pragma unroll
        for (int bj = 0; bj < 2; ++bj) { const int col = u.pn * 256 + bj * 128 + wc * 32 + 8 * fq; bv[bj][0] = *(const f32x4*)(bp + col); bv[bj][1] = *(const f32x4*)(bp + col + 4); }
        asm volatile("" ::: "memory");
#pragma unroll
        for (int ai = 0; ai < 2; ++ai)
#pragma unroll
            for (int m = 0; m < 4; ++m) {
                const int row = u.pm * 256 + ai * 128 + wr * 64 + m * 16 + fr;
                const float rstd = rs[ai * 4 + m];
#pragma unroll
                for (int bj = 0; bj < 2; ++bj) {
                    const int col = u.pn * 256 + bj * 128 + wc * 32 + 8 * fq;
                    const f32x4 b0 = bv[bj][0], b1 = bv[bj][1];
                    float hv[4];
#pragma unroll
                    for (int e = 0; e < 4; ++e) { const float gz = acc[ai][bj][m][0][e] * rstd + b0[e], uz = acc[ai][bj][m][1][e] * rstd + b1[e]; hv[e] = silu_f(gz) * uz; }
                    u32x2 w; w.x = pk_bf16(hv[0], hv[1]); w.y = pk_bf16(hv[2], hv[3]);
                    *(u32x2*)(H + (size_t)row * D_FF + (col >> 1)) = w;
                }
            }
    }
};

struct Args { const float* in[21]; float* out; unsigned char* ws; int ph_lo, ph_hi; };
struct Frame { lptr lds; int tid, lane, wave, G, bid; inptr_t in; float* out; unsigned char* ws; float* out0; unsigned char* ws0; };

template <class RowMap>
__device__ __forceinline__ void transpose_item(const float* W, int K, int N, bf16_t* WT, LAS float* scr, int item, int lane, RowMap rm) {
    const int nblk = N / 32, kb = item / nblk, nb = item % nblk, k0 = 64 * kb, n0 = 32 * nb;
    {
        const float* src = W + (size_t)(k0 + (lane >> 3)) * N + n0 + 4 * (lane & 7);
        f32x4 v[8];
#pragma unroll
        for (int i = 0; i < 8; ++i) v[i] = *(const f32x4*)(src + (size_t)(8 * i) * N);
#pragma unroll
        for (int i = 0; i < 8; ++i) { LAS float* d = scr + (8 * i + (lane >> 3)) * 33 + 4 * (lane & 7); d[0] = v[i][0]; d[1] = v[i][1]; d[2] = v[i][2]; d[3] = v[i][3]; }
    }
    asm volatile("s_waitcnt lgkmcnt(0)" ::: "memory");
    const int c = lane & 7;
#pragma unroll
    for (int jj = 0; jj < 4; ++jj) { const int n = (lane >> 3) + 8 * jj; const LAS float* s = scr + (8 * c) * 33 + n;
        u32x4 o; o.x = pk_bf16(s[0 * 33], s[1 * 33]); o.y = pk_bf16(s[2 * 33], s[3 * 33]); o.z = pk_bf16(s[4 * 33], s[5 * 33]); o.w = pk_bf16(s[6 * 33], s[7 * 33]);
        *(u32x4*)(WT + (size_t)rm(n0 + n) * K + k0 + 8 * c) = o; }
    asm volatile("s_waitcnt lgkmcnt(0)" ::: "memory");
}
struct RmId { __device__ __forceinline__ int operator()(int n) const { return n; } };
struct RmQkv { __device__ __forceinline__ int operator()(int n) const { if (n >= 1280) return n; const int hb = n & ~127, hl = n & 127, ax = hl >> 6, r = hl & 63, p = r >> 5, jj = r & 31; return hb + ax * 64 + 2 * jj + p; } };
struct RmGU { __device__ __forceinline__ int operator()(int n) const { const int isu = n >= D_FF, i = isu ? n - D_FF : n; return 8 * (i >> 2) + 4 * isu + (i & 3); } };


template <int NKC>
__device__ __forceinline__ void adaln_layer(Frame& F, int l, int wgi, int nwg) {
    const inptr_t in = F.in;
    int* mod = (int*)(F.ws + WS_MOD);
    constexpr int KI = DM / NKC;
    if (wgi < NKC * 6) {
        LAS float* sc = (LAS float*)F.lds;
        for (int i = F.tid; i < NCOND * DM; i += NTHREADS) { const int c = i >> 10, k = i & 1023; const float v = c == 0 ? in[6][k] : in[5][(c - 1) * DM + k]; sc[i] = v / (1.f + __expf(-v)); }
        __syncthreads();
        for (int it = wgi; it < NKC * 6; it += nwg) {
            const int nc = it % 6, kc = it / 6;
            const int n = nc * 1024 + 2 * F.tid, k0 = kc * KI;
            const float* wp = in[7] + ((size_t)l * DM + k0) * 6144 + n;
            float a[NCOND][2];
#pragma unroll
            for (int c = 0; c < NCOND; ++c) { a[c][0] = 0.f; a[c][1] = 0.f; }
            for (int kb = 0; kb < KI; kb += 16) {
                f32x2 w[16];
#pragma unroll
                for (int k = 0; k < 16; ++k) w[k] = *(const f32x2*)(wp + (size_t)(kb + k) * 6144);
#pragma unroll
                for (int k = 0; k < 16; ++k)
#pragma unroll
                    for (int c = 0; c < NCOND; ++c) { const float sv = sc[c * DM + k0 + kb + k]; a[c][0] += sv * w[k].x; a[c][1] += sv * w[k].y; }
            }
            if (kc == 0) { const f32x2 b = *(const f32x2*)(in[8] + (size_t)l * 6144 + n);
#pragma unroll
                for (int c = 0; c < NCOND; ++c) { a[c][0] += b.x; a[c][1] += b.y; } }
#pragma unroll
            for (int c = 0; c < NCOND; ++c) { int* mp = mod + (size_t)(c * 4 + l) * 6144 + n; atomicAdd(mp, __float2int_rn(a[c][0] * MOD_SCALE)); atomicAdd(mp + 1, __float2int_rn(a[c][1] * MOD_SCALE)); }
        }
    }
    __syncthreads();
}

__device__ __forceinline__ void convert_set(Frame& F, int set, int gw, int NGW) {
    const inptr_t in = F.in;
    LAS float* scr = (LAS float*)(F.lds + F.wave * 16384);
    constexpr int I_IN = 16 * 160, I_SQ = 16 * 32, I_QKV = 16 * 48, I_GU = 16 * 176, I_DN = 44 * 32;
    const bool hgl = (set == 0 || set == 2);
    const int l = set == 0 ? 0 : (set == 1 ? 1 : (set == 4 ? 3 : 2)), j = l >> 1;
    const int n0 = set == 3 ? 0 : (hgl ? I_IN : I_QKV), n1 = set == 3 ? 0 : I_SQ, n2 = set == 2 ? 0 : I_GU, n3 = set == 2 ? 0 : I_DN;
    const int t0 = n0, t1 = t0 + n1, t2 = t1 + n2, t3 = t2 + n3;
    for (int it = gw; it < t3; it += NGW) {
        if (it < t0) { if (hgl) transpose_item(in[14] + (size_t)j * DM * A_IN, DM, A_IN, (bf16_t*)(F.ws + WS_W_IN) + (size_t)j * A_IN * DM, scr, it, F.lane, RmId());
                       else transpose_item(in[18] + (size_t)j * DM * QKV_N, DM, QKV_N, (bf16_t*)(F.ws + WS_W_QKV) + (size_t)j * QKV_N * DM, scr, it, F.lane, RmQkv()); }
        else if (it < t1) { const int r = it - t0; if (hgl) transpose_item(in[17] + (size_t)j * DM * DM, DM, DM, (bf16_t*)(F.ws + WS_W_OUTA) + (size_t)j * DM * DM, scr, r, F.lane, RmId());
                            else transpose_item(in[19] + (size_t)j * DM * DM, DM, DM, (bf16_t*)(F.ws + WS_W_OUTB) + (size_t)j * DM * DM, scr, r, F.lane, RmId()); }
        else if (it < t2) { const int r = it - t1; transpose_item(in[12] + (size_t)l * DM * GU_N, DM, GU_N, (bf16_t*)(F.ws + WS_W_GU) + (size_t)l * GU_N * DM, scr, r, F.lane, RmGU()); }
        else { const int r = it - t2; transpose_item(in[13] + (size_t)l * D_FF * DM, D_FF, DM, (bf16_t*)(F.ws + WS_W_DN) + (size_t)l * DM * D_FF, scr, r, F.lane, RmId()); }
    }
}
__device__ __forceinline__ void bias_layer(Frame& F, int l, int gw, int NGW) {
    const int* mod = (const int*)(F.ws + WS_MOD);
    const bool hg = (l & 1) == 0; const int j = l >> 1;
    const int part = gw & 1, gwp = gw >> 1, NW = NGW >> 1;
    const int N = part ? GU_N : (hg ? A_IN : QKV_N), shoff = part ? 3072 : 0;
    const bf16_t* wt = part ? (const bf16_t*)(F.ws + WS_W_GU) + (size_t)l * GU_N * DM : (hg ? (const bf16_t*)(F.ws + WS_W_IN) + (size_t)j * A_IN * DM : (const bf16_t*)(F.ws + WS_W_QKV) + (size_t)j * QKV_N * DM);
    float* bout = part ? (float*)(F.ws + WS_BIAS_GU) + (size_t)l * NCOND * GU_N : (hg ? (float*)(F.ws + WS_BIAS_IN) + (size_t)j * NCOND * A_IN : (float*)(F.ws + WS_BIAS_QKV) + (size_t)j * NCOND * QKV_N);
    float sh[NCOND][16];
#pragma unroll
    for (int c = 0; c < NCOND; ++c)
#pragma unroll
        for (int h = 0; h < 2; ++h) { const int* sp = mod + (size_t)(c * 4 + l) * 6144 + shoff + 512 * h + 8 * F.lane; const f32x4 a = modv4(sp), b = modv4(sp + 4);
#pragma unroll
            for (int e = 0; e < 4; ++e) { sh[c][8 * h + e] = a[e]; sh[c][8 * h + 4 + e] = b[e]; } }
    for (int r0 = 4 * gwp; r0 < N; r0 += 4 * NW) {
        const bf16_t* wrow = wt + (size_t)r0 * DM;
        u32x4 wv4[4][2];
#pragma unroll
        for (int q = 0; q < 4; ++q)
#pragma unroll
            for (int h = 0; h < 2; ++h) wv4[q][h] = *(const u32x4*)(wrow + (size_t)q * DM + 512 * h + 8 * F.lane);
        float acc[4][NCOND];
#pragma unroll
        for (int q = 0; q < 4; ++q) {
#pragma unroll
            for (int c = 0; c < NCOND; ++c) acc[q][c] = 0.f;
#pragma unroll
            for (int h = 0; h < 2; ++h) { const u32x4 w = wv4[q][h];
                const float wv[8] = {bf_lo(w.x), bf_hi(w.x), bf_lo(w.y), bf_hi(w.y), bf_lo(w.z), bf_hi(w.z), bf_lo(w.w), bf_hi(w.w)};
#pragma unroll
                for (int c = 0; c < NCOND; ++c)
#pragma unroll
                    for (int e = 0; e < 8; ++e) acc[q][c] += sh[c][8 * h + e] * wv[e]; }
        }
#pragma unroll
        for (int o = 1; o < 64; o <<= 1)
#pragma unroll
            for (int q = 0; q < 4; ++q)
#pragma unroll
                for (int c = 0; c < NCOND; ++c) acc[q][c] += __shfl_xor(acc[q][c], o);
        if (F.lane == 0) {
#pragma unroll
            for (int q = 0; q < 4; ++q)
#pragma unroll
                for (int c = 0; c < NCOND; ++c) bout[(size_t)c * N + r0 + q] = acc[q][c];
        }
    }
}

__device__ __forceinline__ void phase0a(Frame& F) {
    const int gw = F.bid * NWAVES + F.wave, NGW = F.G * NWAVES;
    const inptr_t in = F.in;
    adaln_layer<32>(F, 0, F.bid, F.G);
    convert_set(F, 0, gw, NGW);
    const int gt = F.bid * NTHREADS + F.tid, NGT = F.G * NTHREADS;
    for (int i = gt; i < 2 * 1024; i += NGT) { const float a = in[15][i], b = in[15][2048 + i]; const float mx = fmaxf(a, b), ea = __expf(a - mx), eb = __expf(b - mx);
        float* lb = (float*)(F.ws + WS_LB); lb[i] = 0.f; lb[2048 + i] = eb / (ea + eb); }
    for (int i = gt; i < 2 * 64 * 32; i += NGT) { const int jx = i & 31, pos = (i >> 5) & 63; const float inv = exp2f(-(float)jx * (13.287712379549449f / 32.f)); const float ang = (float)pos * inv;
        float* rp = (float*)(F.ws + WS_ROPE); rp[i] = cosf(ang); rp[2 * 64 * 32 + i] = sinf(ang); }
    for (int i = gt; i < 4 * 2 * 512 * 2 * 16; i += NGT) {
        const int rowid = i >> 4, o0 = (i & 15) * 8; float v[8];
#pragma unroll
        for (int e = 0; e < 8; ++e) { const int hl = o0 + e, ax = hl >> 6, r = hl & 63, jj = r >> 1, p = r & 1; v[e] = in[2][(size_t)rowid * 128 + ax * 64 + 32 * p + jj]; }
        u32x4 w; w.x = pk_bf16(v[0], v[1]); w.y = pk_bf16(v[2], v[3]); w.z = pk_bf16(v[4], v[5]); w.w = pk_bf16(v[6], v[7]);
        *(u32x4*)((bf16_t*)(F.ws + WS_CK) + (size_t)rowid * 128 + o0) = w;
    }
    for (int i = gt; i < 4 * 2 * 2 * 64 * 128; i += NGT) {
        const int d = i & 127, p8 = (i >> 7) & 63, kvh = (i >> 13) & 1, bj = i >> 14; float v[8];
#pragma unroll
        for (int e = 0; e < 8; ++e) v[e] = in[3][((size_t)(bj * 512 + p8 * 8 + e) * 2 + kvh) * 128 + d];
        u32x4 w; w.x = pk_bf16(v[0], v[1]); w.y = pk_bf16(v[2], v[3]); w.z = pk_bf16(v[4], v[5]); w.w = pk_bf16(v[6], v[7]);
        *(u32x4*)((bf16_t*)(F.ws + WS_CVT) + ((size_t)(bj * 2 + kvh) * 128 + d) * 512 + p8 * 8) = w;
    }
}

__device__ __forceinline__ void phase0b(Frame& F) {
    const int gw = F.bid * NWAVES + F.wave, NGW = F.G * NWAVES;
    const int* mod = (const int*)(F.ws + WS_MOD);
    for (int row0 = 2 * gw; row0 < M_TOT; row0 += 2 * NGW) {
        const int cond = cond_of_row(row0);
        const float* nw = F.in[9]; const int* sc = mod + (size_t)(cond * 4 + 0) * 6144 + 1024;
        f32x4 xv[2][4], wv[4];
#pragma unroll
        for (int jx = 0; jx < 4; ++jx) { const int k = 4 * F.lane + 256 * jx; wv[jx] = *(const f32x4*)(nw + k) * (modv4(sc + k) + 1.f); }
#pragma unroll
        for (int q = 0; q < 2; ++q) { const int row = row0 + q; const float* xr = row < M_CTX ? F.in[0] + (size_t)row * DM : F.in[1] + (size_t)(row - M_CTX) * DM;
#pragma unroll
            for (int jx = 0; jx < 4; ++jx) xv[q][jx] = *(const f32x4*)(xr + 4 * F.lane + 256 * jx); }
        asm volatile("" ::: "memory");
#pragma unroll
        for (int q = 0; q < 2; ++q) { const int row = row0 + q; bf16_t* dst = (bf16_t*)(F.ws + WS_XA) + (size_t)row * DM; float sq = 0.f;
#pragma unroll
            for (int jx = 0; jx < 4; ++jx) { const int k = 4 * F.lane + 256 * jx; const f32x4 v = xv[q][jx];
                sq += (v.x * v.x + v.y * v.y) + (v.z * v.z + v.w * v.w);
                const f32x4 a = v * wv[jx]; u32x2 w; w.x = pk_bf16(a[0], a[1]); w.y = pk_bf16(a[2], a[3]); *(u32x2*)(dst + k) = w; }
            sq = wave_sum(sq);
            if (F.lane == 0) ((unsigned*)(F.ws + WS_SS))[row] = (unsigned)(sq * SS_SCALE + 0.5f); }
    }
    bias_layer(F, 0, gw, NGW);
}

constexpr int SB_QP = 0, SB_KP = SB_QP + 32 * 272, SB_KPT = SB_KP + 32 * 272, SB_VT = SB_KPT + 128 * 80, SB_D15 = SB_VT + 128 * 80, SB_DX = SB_D15 + 512, SB_SIZE = SB_DX + 512;
constexpr int SC_OT = 2 * SB_SIZE, SC_OTSZ = 32 * 272, SC_OFW = SC_OT + 2 * SC_OTSZ, SC_END = SC_OFW + 256 * 256;
static_assert(SC_END <= 163840 - 256, "scan lds");
struct ScanP { const bf16_t* Q; const bf16_t* V; bf16_t* KF; bf16_t* KB; const unsigned short* GF; const unsigned short* GB; const float* s_in; float* s_out; float* useg; float* dseg; int j; bf16_t* OFW; bf16_t* A2; const float* gn; };
struct ScanRegs { unsigned q[4], g[4], v[4]; };

template <bool LIGHT>
__device__ __forceinline__ void scan_load(ScanRegs& R, const bf16_t* Q, const bf16_t* Kp, const unsigned short* Gp, const bf16_t* V, int rowbase, int T, int dir, int ilc, int tg, int coloff) {
#pragma unroll
    for (int ii = 0; ii < 4; ++ii) { const int il = ilc + 4 * tg + ii; const int tok = dir ? (T - 1 - il) : il; const int ro = (rowbase + tok) * DM + coloff;
        if (!LIGHT) R.q[ii] = *(const unsigned*)(Q + ro); R.g[ii] = *(const unsigned*)(Gp + ro); R.v[ii] = *(const unsigned*)(V + ro); }
}
template <bool LIGHT>
__device__ __forceinline__ void scan_compute(lptr Lb, const ScanRegs& R, int lane, int w, float (&dacc)[2]) {
    const int tg = lane >> 3, dp = lane & 7;
    float cl[4][2], kq0[4][2]; float t0 = 0.f, t1 = 0.f;
#pragma unroll
    for (int ii = 0; ii < 4; ++ii) { const f32x2 gg = unpk_f16(R.g[ii]); t0 += gg.x; t1 += gg.y; cl[ii][0] = t0; cl[ii][1] = t1; kq0[ii][0] = 1.f - fast_exp2(gg.x); kq0[ii][1] = 1.f - fast_exp2(gg.y); }
    float s0 = t0, s1 = t1;
    { float u0 = __shfl_up(s0, 8), u1 = __shfl_up(s1, 8); if (tg >= 1) { s0 += u0; s1 += u1; } }
    { float u0 = __shfl_up(s0, 16), u1 = __shfl_up(s1, 16); if (tg >= 2) { s0 += u0; s1 += u1; } }
    { float u0 = __shfl_up(s0, 32), u1 = __shfl_up(s1, 32); if (tg >= 4) { s0 += u0; s1 += u1; } }
    const float b15[2] = {__shfl(s0, 24 + dp), __shfl(s1, 24 + dp)}, b31[2] = {__shfl(s0, 56 + dp), __shfl(s1, 56 + dp)};
    const float pre[2] = {s0 - t0 - b15[0], s1 - t1 - b15[1]};
    const int pos = 32 * (w >> 1) + 8 * (dp >> 1) + 4 * (w & 1) + 2 * (dp & 1);
    const int p0 = 8 * (tg & 3) + 4 * (tg >> 2);
    float kt[2][4];
#pragma unroll
    for (int ii = 0; ii < 4; ++ii) {
        const int i = 4 * tg + ii;
        float kq[2], qq[2];
#pragma unroll
        for (int x = 0; x < 2; ++x) {
            const float dl = pre[x] + cl[ii][x];
            const float kv = kq0[ii][x];
            kq[x] = kv * fast_exp2(fminf(-dl, 100.f)); kt[x][ii] = kq[x];
            if constexpr (!LIGHT) { const float qv = x ? bf_hi(R.q[ii]) : bf_lo(R.q[ii]); qq[x] = qv * fast_exp2(fminf(dl, 100.f)); }
        }
        if constexpr (!LIGHT) {
            *(LAS unsigned*)(Lb + SB_QP + i * 272 + 2 * pos) = pk_bf16(qq[0], qq[1]);
            *(LAS unsigned*)(Lb + SB_KP + i * 272 + 2 * pos) = pk_bf16(kq[0], kq[1]);
        }
    }
    const int d0 = 16 * w + 2 * dp;
#pragma unroll
    for (int x = 0; x < 2; ++x) { u32x2 v; v.x = pk_bf16(kt[x][0], kt[x][1]); v.y = pk_bf16(kt[x][2], kt[x][3]); *(LAS u32x2*)(Lb + SB_KPT + (d0 + x) * 80 + 2 * p0) = v; }
    { u32x2 v0, v1; v0.x = (R.v[0] & 0xffffu) | (R.v[1] << 16); v0.y = (R.v[2] & 0xffffu) | (R.v[3] << 16); v1.x = (R.v[0] >> 16) | (R.v[1] & 0xffff0000u); v1.y = (R.v[2] >> 16) | (R.v[3] & 0xffff0000u);
      *(LAS u32x2*)(Lb + SB_VT + d0 * 80 + 2 * p0) = v0; *(LAS u32x2*)(Lb + SB_VT + (d0 + 1) * 80 + 2 * p0) = v1; }
    if (tg == 0) { *(LAS f32x2*)(Lb + SB_D15 + 4 * d0) = (f32x2){fast_exp2(b15[0]), fast_exp2(b15[1])}; *(LAS f32x2*)(Lb + SB_DX + 4 * d0) = (f32x2){fast_exp2(b31[0] - b15[0]), fast_exp2(b31[1] - b15[1])}; }
    dacc[0] += b31[0]; dacc[1] += b31[1];
}
template <bool LIGHT>
__device__ __forceinline__ void scan_mfma(lptr Lb, lptr Lot, int ost, f32x4 (&S)[8], int lane, int w) {
    const int g = lane >> 4, c = lane & 15;
#pragma unroll
    for (int a = 0; a < 8; ++a) S[a] = S[a] * *(const LAS f32x4*)(Lb + SB_D15 + (16 * a + 4 * g) * 4);
    const bf16x8 vb = *(const LAS bf16x8*)(Lb + SB_VT + (16 * w + c) * 80 + 16 * g);
    f32x4 ao0 = {0.f, 0.f, 0.f, 0.f}, ao1 = {0.f, 0.f, 0.f, 0.f};
    if constexpr (!LIGHT) {
        bf16x8 qa[2][4];
#pragma unroll
        for (int it = 0; it < 2; ++it)
#pragma unroll
            for (int ks = 0; ks < 4; ++ks) qa[it][ks] = *(const LAS bf16x8*)(Lb + SB_QP + (16 * it + c) * 272 + 64 * ks + 16 * g);
        f32x4 ao[2] = {(f32x4){0.f, 0.f, 0.f, 0.f}, (f32x4){0.f, 0.f, 0.f, 0.f}};
#pragma unroll
        for (int ks = 0; ks < 4; ++ks) {
            u32x4 sw; sw.x = pk_bf16(S[2 * ks][0], S[2 * ks][1]); sw.y = pk_bf16(S[2 * ks][2], S[2 * ks][3]); sw.z = pk_bf16(S[2 * ks + 1][0], S[2 * ks + 1][1]); sw.w = pk_bf16(S[2 * ks + 1][2], S[2 * ks + 1][3]);
            const bf16x8 sb = __builtin_bit_cast(bf16x8, sw);
            ao[0] = __builtin_amdgcn_mfma_f32_16x16x32_bf16(qa[0][ks], sb, ao[0], 0, 0, 0);
            ao[1] = __builtin_amdgcn_mfma_f32_16x16x32_bf16(qa[1][ks], sb, ao[1], 0, 0, 0);
        }
        f32x4 t00 = {0.f, 0.f, 0.f, 0.f}, t01 = {0.f, 0.f, 0.f, 0.f}, t11 = {0.f, 0.f, 0.f, 0.f};
#pragma unroll
        for (int ks = 0; ks < 4; ++ks) {
            const bf16x8 k0 = *(const LAS bf16x8*)(Lb + SB_KP + c * 272 + 64 * ks + 16 * g), k1 = *(const LAS bf16x8*)(Lb + SB_KP + (16 + c) * 272 + 64 * ks + 16 * g);
            t00 = __builtin_amdgcn_mfma_f32_16x16x32_bf16(k0, qa[0][ks], t00, 0, 0, 0);
            t01 = __builtin_amdgcn_mfma_f32_16x16x32_bf16(k0, qa[1][ks], t01, 0, 0, 0);
            t11 = __builtin_amdgcn_mfma_f32_16x16x32_bf16(k1, qa[1][ks], t11, 0, 0, 0);
        }
#pragma unroll
        for (int r = 0; r < 4; ++r) { if (4 * g + r > c) { t00[r] = 0.f; t11[r] = 0.f; } }
        { u32x4 pw; pw.x = pk_bf16(t00[0], t00[1]); pw.y = pk_bf16(t00[2], t00[3]); pw.z = 0u; pw.w = 0u;
          ao[0] = __builtin_amdgcn_mfma_f32_16x16x32_bf16(__builtin_bit_cast(bf16x8, pw), vb, ao[0], 0, 0, 0); }
        { u32x4 pw; pw.x = pk_bf16(t01[0], t01[1]); pw.y = pk_bf16(t01[2], t01[3]); pw.z = pk_bf16(t11[0], t11[1]); pw.w = pk_bf16(t11[2], t11[3]);
          ao[1] = __builtin_amdgcn_mfma_f32_16x16x32_bf16(__builtin_bit_cast(bf16x8, pw), vb, ao[1], 0, 0, 0); }
        ao0 = ao[0]; ao1 = ao[1];
    }
#pragma unroll
    for (int a = 0; a < 8; ++a) {
        const bf16x8 ka = *(const LAS bf16x8*)(Lb + SB_KPT + (16 * a + c) * 80 + 16 * g);
        S[a] = __builtin_amdgcn_mfma_f32_16x16x32_bf16(ka, vb, S[a], 0, 0, 0) * *(const LAS f32x4*)(Lb + SB_DX + (16 * a + 4 * g) * 4);
    }
    if constexpr (!LIGHT) {
#pragma unroll
        for (int r = 0; r < 4; ++r) { *(LAS bf16_t*)(Lot + (4 * g + r) * ost + (16 * w + c) * 2) = to_bf16(ao0[r]); *(LAS bf16_t*)(Lot + (16 + 4 * g + r) * ost + (16 * w + c) * 2) = to_bf16(ao1[r]); }
    }
}
struct FlushRegs { u32x4 sg; };
__device__ __forceinline__ void scan_flush_pre(FlushRegs& R, const ScanP& P, int rowbase, int T, int ilc, int h, int tid) {
    const int i = tid >> 4, ch = tid & 15; const int il = ilc + i; const int tok = T - 1 - il; const int off = (rowbase + tok) * DM + h * 128 + 8 * ch;
    R.sg = *(const u32x4*)(P.A2 + off);
}
__device__ __forceinline__ void scan_flush(lptr Lot, lptr Lofw, const FlushRegs& R, const ScanP& P, int rowbase, int T, int ilc, int lo, int h, int tid) {
    const int i = tid >> 4, ch = tid & 15; const int il = ilc + i; const int tok = T - 1 - il;
    const int off = (rowbase + tok) * DM + h * 128 + 8 * ch;
    const u32x4 ob = *(const LAS u32x4*)(Lot + i * 272 + 16 * ch);
    const u32x4 of = *(const LAS u32x4*)(Lofw + (255 - (lo + i)) * 256 + 16 * ch);
    const u32x4 sg = R.sg;
    const f32x4 g0 = *(const f32x4*)(P.gn + h * 128 + 8 * ch), g1 = *(const f32x4*)(P.gn + h * 128 + 8 * ch + 4);
    float v[8];
#pragma unroll
    for (int e = 0; e < 4; ++e) { v[2 * e] = bf_lo(of[e]) + bf_lo(ob[e]); v[2 * e + 1] = bf_hi(of[e]) + bf_hi(ob[e]); }
    float sq = 0.f;
#pragma unroll
    for (int e = 0; e < 8; ++e) sq += v[e] * v[e];
    sq += __shfl_xor(sq, 1); sq += __shfl_xor(sq, 2); sq += __shfl_xor(sq, 4); sq += __shfl_xor(sq, 8);
    const float rs = rsqrtf(sq * (1.f / 128.f) + EPS);
    u32x4 w;
    w.x = pk_bf16(v[0] * rs * g0[0] * bf_lo(sg.x), v[1] * rs * g0[1] * bf_hi(sg.x)); w.y = pk_bf16(v[2] * rs * g0[2] * bf_lo(sg.y), v[3] * rs * g0[3] * bf_hi(sg.y));
    w.z = pk_bf16(v[4] * rs * g1[0] * bf_lo(sg.z), v[5] * rs * g1[1] * bf_hi(sg.z)); w.w = pk_bf16(v[6] * rs * g1[2] * bf_lo(sg.w), v[7] * rs * g1[3] * bf_hi(sg.w));
    *(u32x4*)(P.A2 + off) = w;
}

template <bool LIGHT>
__device__ __forceinline__ void scan_item(Frame& F, const ScanP& P, int rowbase, int T, int il0, int nch, int h, int dir,
                                          const float* s0, int nfold, const float* fu, const float* fd, float* sfin, float* dout) {
    const lptr L = F.lds; const int lane = F.lane, w = F.wave, g = lane >> 4, c = lane & 15;
    bf16_t* Kp = dir ? P.KB : P.KF; const unsigned short* Gp = dir ? P.GB : P.GF;
    f32x4 S[8];
    {
        int l3 = lane; asm volatile("" : "+v"(l3));
        const int lo = ((l3 >> 4) * 4) * 128 + 16 * w + (l3 & 15);
        if (s0) { const float* sp0 = s0 + lo;
#pragma unroll
            for (int a = 0; a < 8; ++a)
#pragma unroll
                for (int r = 0; r < 4; ++r) S[a][r] = sp0[(16 * a + r) * 128];
        } else {
#pragma unroll
            for (int a = 0; a < 8; ++a) S[a] = (f32x4){0.f, 0.f, 0.f, 0.f};
        }
        if constexpr (!LIGHT) {
            if (nfold > 0) {
                const unsigned short* ub = (const unsigned short*)fu + lo; const float* db = fd + (l3 >> 4) * 4;
                unsigned short U0[32], U1[32]; f32x4 D0[8], D1[8];
#define FOLD_LD(U, D, f_) { const unsigned short* up = ub + (size_t)(f_) * 16384; const float* dp = db + (f_) * 128; \
    _Pragma("unroll") for (int a = 0; a < 8; ++a) { D[a] = *(const f32x4*)(dp + 16 * a); _Pragma("unroll") for (int r = 0; r < 4; ++r) U[4 * a + r] = up[(16 * a + r) * 128]; } }
#define FOLD_DO(U, D) { _Pragma("unroll") for (int a = 0; a < 8; ++a) { _Pragma("unroll") for (int r = 0; r < 4; ++r) S[a][r] = fast_exp2(D[a][r]) * S[a][r] + __uint_as_float((unsigned)U[4 * a + r] << 16); } }
                FOLD_LD(U0, D0, 0)
                for (int f = 0; f < nfold; f += 2) {
                    const int f1 = f + 1 < nfold ? f + 1 : nfold - 1, f2 = f + 2 < nfold ? f + 2 : nfold - 1;
                    FOLD_LD(U1, D1, f1)
                    FOLD_DO(U0, D0)
                    FOLD_LD(U0, D0, f2)
                    if (f + 1 < nfold) FOLD_DO(U1, D1)
                }
#undef FOLD_LD
#undef FOLD_DO
            }
        }
    }
    float dacc[2] = {0.f, 0.f};
    const int tg = lane >> 3, coloff = h * 128 + 16 * w + 2 * (lane & 7);
    ScanRegs RA, RB; FlushRegs FR; FR.sg = (u32x4){0u, 0u, 0u, 0u};
    scan_load<LIGHT>(RA, P.Q, Kp, Gp, P.V, rowbase, T, dir, il0, tg, coloff);
    scan_load<LIGHT>(RB, P.Q, Kp, Gp, P.V, rowbase, T, dir, il0 + 32, tg, coloff);
    scan_compute<LIGHT>(L, RA, lane, w, dacc);
    scan_load<LIGHT>(RA, P.Q, Kp, Gp, P.V, rowbase, T, dir, il0 + 32 * (nch > 2 ? 2 : nch - 1), tg, coloff);
    __syncthreads();
    for (int c2 = 0; c2 < nch; c2 += 2) {
        if (!LIGHT) scan_flush_pre(FR, P, rowbase, T, il0 + 32 * (c2 > 0 ? c2 - 1 : 0), h, F.tid);
        scan_mfma<LIGHT>(L, dir ? L + SC_OT : L + SC_OFW + (32 * c2) * 256, dir ? 272 : 256, S, lane, w);
        scan_compute<LIGHT>(L + SB_SIZE, RB, lane, w, dacc);
        scan_load<LIGHT>(RB, P.Q, Kp, Gp, P.V, rowbase, T, dir, il0 + 32 * (c2 + 3 < nch ? c2 + 3 : nch - 1), tg, coloff);
        if (!LIGHT && dir && c2 > 0) scan_flush(L + SC_OT + SC_OTSZ, L + SC_OFW, FR, P, rowbase, T, il0 + 32 * (c2 - 1), 32 * (c2 - 1), h, F.tid);
        __syncthreads();
        if (!LIGHT) scan_flush_pre(FR, P, rowbase, T, il0 + 32 * c2, h, F.tid);
        scan_mfma<LIGHT>(L + SB_SIZE, dir ? L + SC_OT + SC_OTSZ : L + SC_OFW + (32 * (c2 + 1)) * 256, dir ? 272 : 256, S, lane, w);
        if (c2 + 2 < nch) scan_compute<LIGHT>(L, RA, lane, w, dacc);
        scan_load<LIGHT>(RA, P.Q, Kp, Gp, P.V, rowbase, T, dir, il0 + 32 * (c2 + 4 < nch ? c2 + 4 : nch - 1), tg, coloff);
        if (!LIGHT && dir) scan_flush(L + SC_OT, L + SC_OFW, FR, P, rowbase, T, il0 + 32 * c2, 32 * c2, h, F.tid);
        __syncthreads();
    }
    if (!LIGHT && dir) { scan_flush_pre(FR, P, rowbase, T, il0 + 32 * (nch - 1), h, F.tid); scan_flush(L + SC_OT + SC_OTSZ, L + SC_OFW, FR, P, rowbase, T, il0 + 32 * (nch - 1), 32 * (nch - 1), h, F.tid); }
    if (sfin) {
        int l2 = lane; asm volatile("" : "+v"(l2));
        const int lo2 = ((l2 >> 4) * 4) * 128 + 16 * w + (l2 & 15);
        if constexpr (LIGHT) { unsigned short* sp = (unsigned short*)sfin + lo2;
#pragma unroll
            for (int a = 0; a < 8; ++a)
#pragma unroll
                for (int r = 0; r < 4; ++r) sp[(16 * a + r) * 128] = (unsigned short)(pk_bf16(S[a][r], 0.f) & 0xffffu);
        } else { float* sp = sfin + lo2;
#pragma unroll
            for (int a = 0; a < 8; ++a)
#pragma unroll
                for (int r = 0; r < 4; ++r) sp[(16 * a + r) * 128] = S[a][r];
        }
    }
    if (LIGHT && dout && (lane >> 3) == 0) *(f32x2*)(dout + 16 * w + 2 * (lane & 7)) = (f32x2){dacc[0], dacc[1]};
    asm volatile("s_waitcnt vmcnt(0)" ::: "memory");
    __syncthreads();
}
__device__ __forceinline__ void scan_phase_a(Frame& F, const ScanP& P) {
    for (int it = F.bid; it < 448; it += F.G) {
        const int seq = it / 7, sg = it - seq * 7, b = seq >> 4, h = (seq >> 1) & 7, dir = seq & 1;
        scan_item<true>(F, P, M_CTX + b * 2048, 2048, 256 * sg, 8, h, dir, nullptr, 0, nullptr, nullptr, (float*)((unsigned short*)P.useg + (size_t)it * 16384), P.dseg + it * 128);
    }
}
__device__ __forceinline__ void scan_phase_c(Frame& F, const ScanP& P) {
    for (int it = F.bid; it < 512; it += F.G) {
        for (int dir = 0; dir < 2; ++dir) {
            int rowbase, T, il0, h, nfold; const float* s0; const float* fu; const float* fd; float* sfin;
            if (it < 256) {
                const int b = it >> 6, h_ = (it >> 3) & 7, sg = it & 7; h = h_;
                const int seq = (b * 8 + h) * 2 + dir, sgd = dir ? 7 - sg : sg;
                rowbase = M_CTX + b * 2048; T = 2048; il0 = 256 * sgd; nfold = sgd; s0 = P.s_in + ((size_t)((b * 2 + P.j) * 2 + dir) * 8 + h) * 16384;
                fu = (const float*)((const unsigned short*)P.useg + (size_t)seq * 7 * 16384); fd = P.dseg + seq * 7 * 128; sfin = nullptr;
            } else {
                const int q = it - 256, b = q >> 3; h = q & 7;
                rowbase = b * 256; T = 256; il0 = 0; nfold = 0; s0 = nullptr; fu = nullptr; fd = nullptr; sfin = P.s_out + ((size_t)((b * 2 + P.j) * 2 + dir) * 8 + h) * 16384;
            }
            scan_item<false>(F, P, rowbase, T, il0, 8, h, dir, s0, nfold, fu, fd, sfin, nullptr);
        }
    }
}
__device__ __forceinline__ void combine_phase(Frame& F, const bf16_t* OF, const bf16_t* OB, bf16_t* A2, const float* gn) {
    const int gw = F.bid * NWAVES + F.wave, NGW = F.G * NWAVES;
    const int ch = 16 * F.lane;
    float gv[16];
#pragma unroll
    for (int e = 0; e < 16; e += 4) { const f32x4 t = *(const f32x4*)(gn + ch + e); gv[e] = t[0]; gv[e + 1] = t[1]; gv[e + 2] = t[2]; gv[e + 3] = t[3]; }
    for (int row = gw; row < M_TOT; row += NGW) {
        const size_t o = (size_t)row * DM + ch;
        const u32x4 f0 = *(const u32x4*)(OF + o), f1 = *(const u32x4*)(OF + o + 8), b0 = *(const u32x4*)(OB + o), b1 = *(const u32x4*)(OB + o + 8);
        const u32x4 s0 = *(const u32x4*)(A2 + o), s1 = *(const u32x4*)(A2 + o + 8);
        float v[16]; float sq = 0.f;
#pragma unroll
        for (int e = 0; e < 4; ++e) { v[2 * e] = bf_lo(f0[e]) + bf_lo(b0[e]); v[2 * e + 1] = bf_hi(f0[e]) + bf_hi(b0[e]); v[8 + 2 * e] = bf_lo(f1[e]) + bf_lo(b1[e]); v[8 + 2 * e + 1] = bf_hi(f1[e]) + bf_hi(b1[e]); }
#pragma unroll
        for (int e = 0; e < 16; ++e) sq += v[e] * v[e];
        sq += __shfl_xor(sq, 1); sq += __shfl_xor(sq, 2); sq += __shfl_xor(sq, 4);
        const float rs = rsqrtf(sq * (1.f / 128.f) + EPS);
        u32x4 w0, w1;
#pragma unroll
        for (int e = 0; e < 4; ++e) {
            w0[e] = pk_bf16(v[2 * e] * rs * gv[2 * e] * bf_lo(s0[e]), v[2 * e + 1] * rs * gv[2 * e + 1] * bf_hi(s0[e]));
            w1[e] = pk_bf16(v[8 + 2 * e] * rs * gv[8 + 2 * e] * bf_lo(s1[e]), v[8 + 2 * e + 1] * rs * gv[8 + 2 * e + 1] * bf_hi(s1[e]));
        }
        *(u32x4*)(A2 + o) = w0; *(u32x4*)(A2 + o + 8) = w1;
    }
}

constexpr int AT_K = 0, AT_KSZ = 32 * 272, AT_V = 2 * AT_KSZ, AT_VSZ = 128 * 72, AT_END = AT_V + 2 * AT_VSZ;
static_assert(AT_END <= 131072, "attn lds");
struct AttnP { const bf16_t* Qa; const bf16_t* Ka; const bf16_t* VaT; const bf16_t* CK; const bf16_t* CVT; bf16_t* O; const float* sink; int j; };
__device__ __forceinline__ int crow(int r, int hi) { return (r & 3) + 8 * (r >> 2) + 4 * hi; }

__device__ __forceinline__ void attn_unit(Frame& F, const AttnP& P, int qrow0, int head0, const float* sinkp,
                                          const bf16_t* K0, int kst0, const bf16_t* V0, int vst0, int n0,
                                          const bf16_t* K1, int kst1, const bf16_t* V1, int vst1, int n1, int tok0_1, int tq0) {
    const lptr L = F.lds; const int tid = F.tid, lane = F.lane, w = F.wave, r32 = lane & 31, hi = lane >> 5;
    const int head = head0 + (w & 3), wq = w >> 2;
    const float sink_t = sinkp[head] * LOG2E;
    bf16x8 qf[8];
    { const bf16_t* qp = P.Qa + (size_t)(qrow0 + 32 * wq + r32) * DM + head * 128 + 8 * hi;
#pragma unroll
      for (int ks = 0; ks < 8; ++ks) qf[ks] = *(const bf16x8*)(qp + 16 * ks); }
    f32x16 o[4];
#pragma unroll
    for (int d = 0; d < 4; ++d)
#pragma unroll
        for (int r = 0; r < 16; ++r) o[d][r] = 0.f;
    float mrun = sink_t, lrun = hi == 0 ? 1.f : 0.f;
    const int ntile = (n0 + n1) >> 5, nt0 = n0 >> 5;
    const int tq = tq0 + 32 * wq + r32;
    const int skey = tid >> 4, sch = tid & 15, sd = tid >> 2, svc = tid & 3;
    u32x4 kreg, vreg;
#define AT_LOAD(t) do { int t_ = (t); t_ = t_ < ntile ? t_ : ntile - 1; const bool s1_ = t_ >= nt0; const int u_ = s1_ ? t_ - nt0 : t_; \
        const bf16_t* kp_ = (s1_ ? K1 : K0) + (size_t)(32 * u_ + skey) * (s1_ ? kst1 : kst0) + 8 * sch; const bf16_t* vp_ = (s1_ ? V1 : V0) + (size_t)sd * (s1_ ? vst1 : vst0) + 32 * u_ + 8 * svc; \
        kreg = *(const u32x4*)kp_; vreg = *(const u32x4*)vp_; } while (0)
#define AT_STORE(buf) do { *(LAS u32x4*)(L + AT_K + (buf) * AT_KSZ + skey * 272 + 16 * sch) = kreg; \
        *(LAS u32x2*)(L + AT_V + (buf) * AT_VSZ + sd * 72 + 16 * svc) = (u32x2){vreg.x, vreg.y}; *(LAS u32x2*)(L + AT_V + (buf) * AT_VSZ + sd * 72 + 16 * svc + 8) = (u32x2){vreg.z, vreg.w}; } while (0)
    AT_LOAD(0); AT_STORE(0);
    AT_LOAD(1);
    __syncthreads();
    for (int t = 0; t < ntile; ++t) {
        const int buf = t & 1;
        AT_STORE(buf ^ 1); AT_LOAD(t + 2);
        bool active = true; int kt0 = 0;
        if (t >= nt0) { kt0 = tok0_1 + 32 * (t - nt0); const int tw = tq0 + 32 * wq; active = (kt0 + 31 >= tw - 128) && (kt0 <= tw + 31 + 128); }
        if (active) {
            f32x16 s;
#pragma unroll
            for (int r = 0; r < 16; ++r) s[r] = 0.f;
            const lptr kb = L + AT_K + buf * AT_KSZ + r32 * 272 + 16 * hi;
            {
                bf16x8 kf[8];
#pragma unroll
                for (int ks = 0; ks < 8; ++ks) kf[ks] = *(const LAS bf16x8*)(kb + 32 * ks);
                __builtin_amdgcn_sched_barrier(0);
#pragma unroll
                for (int ks = 0; ks < 8; ++ks) s = __builtin_amdgcn_mfma_f32_32x32x16_bf16(kf[ks], qf[ks], s, 0, 0, 0);
            }
            if (t >= nt0) {
#pragma unroll
                for (int r = 0; r < 16; ++r) { const int dk = kt0 + crow(r, hi) - tq; if (dk > 128 || dk < -128) s[r] = -INFINITY; }
            }
            float tm = s[0];
#pragma unroll
            for (int r = 1; r < 16; ++r) tm = fmaxf(tm, s[r]);
            tm = fmaxf(tm, __shfl_xor(tm, 32));
            const float mn = fmaxf(mrun, tm), alpha = fast_exp2(mrun - mn);
            mrun = mn;
            float ps = 0.f;
#pragma unroll
            for (int r = 0; r < 16; ++r) { s[r] = fast_exp2(s[r] - mn); ps += s[r]; }
            lrun = lrun * alpha + ps;
#pragma unroll
            for (int d = 0; d < 4; ++d)
#pragma unroll
                for (int r = 0; r < 16; ++r) o[d][r] *= alpha;
            bf16x8 pf[2];
#pragma unroll
            for (int kk = 0; kk < 2; ++kk) { u32x4 pw; pw.x = pk_bf16(s[8 * kk + 0], s[8 * kk + 1]); pw.y = pk_bf16(s[8 * kk + 2], s[8 * kk + 3]); pw.z = pk_bf16(s[8 * kk + 4], s[8 * kk + 5]); pw.w = pk_bf16(s[8 * kk + 6], s[8 * kk + 7]); pf[kk] = __builtin_bit_cast(bf16x8, pw); }
            const lptr vbp = L + AT_V + buf * AT_VSZ + r32 * 72 + 8 * hi;
            {
                u32x4 vf[4][2];
#pragma unroll
                for (int d = 0; d < 4; ++d)
#pragma unroll
                    for (int kk = 0; kk < 2; ++kk) { const u32x2 lo = *(const LAS u32x2*)(vbp + d * 32 * 72 + 32 * kk), hh = *(const LAS u32x2*)(vbp + d * 32 * 72 + 32 * kk + 16); vf[d][kk] = (u32x4){lo.x, lo.y, hh.x, hh.y}; }
                __builtin_amdgcn_sched_barrier(0);
#pragma unroll
                for (int kk = 0; kk < 2; ++kk)
#pragma unroll
                    for (int d = 0; d < 4; ++d) o[d] = __builtin_amdgcn_mfma_f32_32x32x16_bf16(__builtin_bit_cast(bf16x8, vf[d][kk]), pf[kk], o[d], 0, 0, 0);
            }
        }
        __syncthreads();
    }
#undef AT_LOAD
#undef AT_STORE
    const float lt = lrun + __shfl_xor(lrun, 32);
    const float inv = fast_rcp(lt);
    bf16_t* op = P.O + (size_t)(qrow0 + 32 * wq + r32) * DM + head * 128 + 4 * hi;
#pragma unroll
    for (int d = 0; d < 4; ++d)
#pragma unroll
        for (int u = 0; u < 4; ++u) { u32x2 v; v.x = pk_bf16(o[d][4 * u] * inv, o[d][4 * u + 1] * inv); v.y = pk_bf16(o[d][4 * u + 2] * inv, o[d][4 * u + 3] * inv); *(u32x2*)(op + 32 * d + 8 * u) = v; }
}
__device__ __forceinline__ void attn_phase(Frame& F, const AttnP& P) {
    for (int u = F.bid; u < 256; u += F.G) {
        { const int b = u >> 3, kvh = (u >> 2) & 1, qb = u & 3;
          attn_unit(F, P, b * 256 + qb * 64, kvh * 4, P.sink + P.j * 8,
                    P.Ka + (size_t)(b * 256) * 256 + kvh * 128, 256, P.VaT + (size_t)(b * 2 + kvh) * 128 * 256, 256, 256,
                    nullptr, 0, nullptr, 0, 0, 0, 0); }
        { const int b = u >> 6, kvh = (u >> 5) & 1, qb = u & 31;
          const int lo = qb * 64 - 128 < 0 ? 0 : qb * 64 - 128, hi = qb * 64 + 192 > 2048 ? 2048 : qb * 64 + 192;
          attn_unit(F, P, M_CTX + b * 2048 + qb * 64, kvh * 4, P.sink + P.j * 8,
                    P.CK + ((size_t)(b * 2 + P.j) * 512) * 256 + kvh * 128, 256, P.CVT + (size_t)((b * 2 + P.j) * 2 + kvh) * 128 * 512, 512, 512,
                    P.Ka + (size_t)(M_CTX + b * 2048 + lo) * 256 + kvh * 128, 256, P.VaT + (size_t)2097152 + (size_t)(b * 2 + kvh) * 128 * 2048 + lo, 2048, hi - lo, lo, qb * 64); }
    }
}

__device__ __forceinline__ void final_phase(Frame& F) {
    const int gw = F.bid * NWAVES + F.wave, NGW = F.G * NWAVES;
    const unsigned* ss = (const unsigned*)(F.ws + WS_SS) + (size_t)8 * M_TOT;
    const f32x4 nf[4] = {*(const f32x4*)(F.in[11] + 4 * F.lane), *(const f32x4*)(F.in[11] + 4 * F.lane + 256), *(const f32x4*)(F.in[11] + 4 * F.lane + 512), *(const f32x4*)(F.in[11] + 4 * F.lane + 768)};
    for (int row0 = 4 * gw; row0 < M_TOT; row0 += 4 * NGW) {
        u32x2 xw[4][4]; float rstd[4];
#pragma unroll
        for (int q = 0; q < 4; ++q) { rstd[q] = ss_rstd(ss, row0 + q); const bf16_t* xr = (const bf16_t*)(F.ws + WS_XB) + (size_t)(row0 + q) * DM;
#pragma unroll
            for (int jx = 0; jx < 4; ++jx) xw[q][jx] = *(const u32x2*)(xr + 4 * F.lane + 256 * jx); }
        asm volatile("" ::: "memory");
#pragma unroll
        for (int q = 0; q < 4; ++q) { float* yr = F.out + (size_t)(row0 + q) * DM;
#pragma unroll
            for (int jx = 0; jx < 4; ++jx) { const u32x2 t = xw[q][jx]; const f32x4 v = {bf_lo(t.x), bf_hi(t.x), bf_lo(t.y), bf_hi(t.y)}; *(f32x4*)(yr + 4 * F.lane + 256 * jx) = v * rstd[q] * nf[jx]; } }
    }
}

constexpr int LDS_BYTES = 163840, MISC_OFF = 163840 - 256;
constexpr int NPHASE = 25;
#ifndef KMASK
#define KMASK 0x7ff
#endif
#define KON(k) (((KMASK) >> (k)) & 1)
#ifndef PROBE_MASK
#define PROBE_MASK 0u
#endif
#ifndef PROBE_MULT
#define PROBE_MULT 8
#endif

template <int PH>
__device__ __forceinline__ void run_phase(Frame& F) {
    { size_t z0 = 0, z1 = 0; asm volatile("" : "+s"(z0), "+s"(z1)); F.ws = F.ws0 + z0; F.out = F.out0 + z1; asm volatile("" : "+s"(F.in.p)); }
    asm volatile("" : "+s"(F.wave));
    F.lane = __builtin_amdgcn_mbcnt_hi(~0u, __builtin_amdgcn_mbcnt_lo(~0u, 0u)); asm volatile("" : "+v"(F.lane)); F.tid = F.wave * 64 + F.lane;
    unsigned char* ws = F.ws;
    if constexpr (PH == 0) { if (KON(0)) phase0a(F); }
    else if constexpr (PH == 1) { if (KON(1)) phase0b(F); }
    else if constexpr (PH == NPHASE - 1) { if (KON(2)) final_phase(F); }
    else {
        constexpr int p = PH - 2;
        constexpr int l = p < 6 ? 0 : (p < 11 ? 1 : (p < 17 ? 2 : 3));
        constexpr int sub = p < 6 ? p : (p < 11 ? p - 6 : (p < 17 ? p - 11 : p - 17));
        constexpr bool hg = (l & 1) == 0; constexpr int j = l >> 1;
        constexpr int s_mix = hg ? 3 : 2, s_gu = s_mix + 1, s_dn = s_mix + 2;
        pg8::StaticOrder S;
        if constexpr (sub == 0 && hg) { if (KON(3)) {
            pg8::Gemm g{(const bf16_t*)(ws + WS_XA), (const bf16_t*)(ws + WS_W_IN) + (size_t)j * A_IN * DM, M_TOT, A_IN, DM}; S.init(M_TOT, A_IN, F.G, F.bid);
            EpiIn E{ws, l};
            pg8::gemm_phase(F.lds, F.tid, g, S, E);
        } } else if constexpr ((sub == 1 || sub == 2) && hg) { if (KON(4)) {
            ScanP P{(const bf16_t*)(ws + WS_HQ), (const bf16_t*)(ws + WS_HV), (bf16_t*)(ws + WS_HKF), (bf16_t*)(ws + WS_HKB), (const unsigned short*)(ws + WS_HGF), (const unsigned short*)(ws + WS_HGB),
                    F.in[4], F.out + OUT_ST, (float*)(ws + WS_XA), (float*)(ws + WS_XA) + (size_t)448 * 16384, j, (bf16_t*)(ws + WS_OFW), (bf16_t*)(ws + WS_A2), F.in[16] + (size_t)j * DM};
            if constexpr (sub == 1) scan_phase_a(F, P); else scan_phase_c(F, P);
        } } else if constexpr (sub == 0 && !hg) { if (KON(6)) {
            pg8::Gemm g{(const bf16_t*)(ws + WS_XA), (const bf16_t*)(ws + WS_W_QKV) + (size_t)j * QKV_N * DM, M_TOT, QKV_N, DM}; S.init(M_TOT, QKV_N, F.G, F.bid);
            EpiQkv E{ws, F.out, l};
            pg8::gemm_phase(F.lds, F.tid, g, S, E);
            if constexpr (l == 1) { if (F.bid >= 128) { __syncthreads(); adaln_layer<8>(F, 2, F.bid - 128, F.G - 128); convert_set(F, 2, (F.bid - 128) * NWAVES + F.wave, (F.G - 128) * NWAVES); } }
        } } else if constexpr (sub == 1 && !hg) { if (KON(7)) {
            AttnP P{(const bf16_t*)(ws + WS_AQ), (const bf16_t*)(ws + WS_AK), (const bf16_t*)(ws + WS_AVT), (const bf16_t*)(ws + WS_CK), (const bf16_t*)(ws + WS_CVT), (bf16_t*)(ws + WS_A2), F.in[20], j};
            attn_phase(F, P);
        } } else if constexpr (sub == s_mix) { if (KON(8)) {
            const bf16_t* wt = hg ? (const bf16_t*)(ws + WS_W_OUTA) + (size_t)j * DM * DM : (const bf16_t*)(ws + WS_W_OUTB) + (size_t)j * DM * DM;
            pg8::Gemm g{(const bf16_t*)(ws + WS_A2), wt, M_TOT, DM, DM}; S.init(M_TOT, DM, F.G, F.bid);
            EpiRes E{ws, F.out, F.in, l, 0};
            pg8::gemm_phase(F.lds, F.tid, g, S, E);
        } } else if constexpr (sub == s_gu) { if (KON(9)) {
            pg8::Gemm g{(const bf16_t*)(ws + WS_XA), (const bf16_t*)(ws + WS_W_GU) + (size_t)l * GU_N * DM, M_TOT, GU_N, DM}; S.init(M_TOT, GU_N, F.G, F.bid);
            EpiGU E{ws, l};
            pg8::gemm_phase(F.lds, F.tid, g, S, E);
            if constexpr (l < 3) { if (F.bid >= 128) { __syncthreads(); if constexpr (l != 1) adaln_layer<8>(F, l + 1, F.bid - 128, F.G - 128); convert_set(F, l == 0 ? 1 : (l == 1 ? 3 : 4), (F.bid - 128) * NWAVES + F.wave, (F.G - 128) * NWAVES); } }
        } } else if constexpr (sub == s_dn) { if (KON(10)) {
            pg8::Gemm g{(const bf16_t*)(ws + WS_H), (const bf16_t*)(ws + WS_W_DN) + (size_t)l * DM * D_FF, M_TOT, DM, D_FF}; S.init(M_TOT, DM, F.G, F.bid);
            EpiRes E{ws, F.out, F.in, l, 1};
            pg8::gemm_phase(F.lds, F.tid, g, S, E);
            if constexpr (l < 3) bias_layer(F, l + 1, F.bid * NWAVES + F.wave, F.G * NWAVES);
        } }
    }
}

__global__ void __launch_bounds__(NTHREADS, 2) mk_fwd(Args args) {
    extern __shared__ __attribute__((aligned(16))) unsigned char lds_raw[];
    Frame F; F.lds = (lptr)lds_raw; F.tid = threadIdx.x; F.lane = F.tid & 63; F.wave = __builtin_amdgcn_readfirstlane(F.tid >> 6); F.G = gridDim.x; F.bid = blockIdx.x;
    F.in.p = (__attribute__((address_space(4))) const cfp_t*)__builtin_amdgcn_kernarg_segment_ptr(); F.out = args.out; F.ws = args.ws; F.out0 = args.out; F.ws0 = args.ws;
    volatile LAS unsigned* MISC = (volatile LAS unsigned*)(F.lds + MISC_OFF);
    if (F.tid < 32) MISC[F.tid] = 0u;
    __syncthreads();
    XcdBarrier bar = xcd_barrier_post((unsigned*)(F.ws + WS_CTL) + 4096, MISC + 8);
    const int lo = args.ph_lo, hi = args.ph_hi;
    unsigned long long pt_prev = 0ull, pt_acc = 0ull;
    if (PROBE_MASK) pt_prev = __builtin_amdgcn_s_memrealtime();
#define RUN(PH) if (lo <= (PH) && (PH) < hi) { run_phase<PH>(F); \
        if ((PH) + 1 < hi) { { bar.bar = (unsigned*)(F.ws0 + WS_CTL) + 4096; xcd_barrier(bar); } } \
        if (PROBE_MASK) { const unsigned long long t_ = __builtin_amdgcn_s_memrealtime(); if ((PROBE_MASK >> (PH)) & 1u) pt_acc += t_ - pt_prev; pt_prev = t_; } }
    RUN(0) RUN(1) RUN(2) RUN(3) RUN(4) RUN(5) RUN(6) RUN(7) RUN(8) RUN(9) RUN(10) RUN(11) RUN(12)
    RUN(13) RUN(14) RUN(15) RUN(16) RUN(17) RUN(18) RUN(19) RUN(20) RUN(21) RUN(22) RUN(23) RUN(24)
#undef RUN
    if (PROBE_MASK) { if (blockIdx.x == 0) { const unsigned long long t0 = __builtin_amdgcn_s_memrealtime(); while (__builtin_amdgcn_s_memrealtime() - t0 < (unsigned long long)PROBE_MULT * pt_acc) __builtin_amdgcn_s_sleep(8); } }
}

extern "C" void kernel_launch(void* const* d_in, const int* in_sizes, int n_in, void* d_out, int out_size, void* d_ws, size_t ws_size, hipStream_t stream) {
    static int grid = 0;
    if (grid == 0) {
        if (n_in != 21 || out_size != (int)OUT_TOTAL || ws_size < WS_END) { fprintf(stderr, "kernel_launch: unexpected shapes: n_in %d out %d ws %zu (need %zu)\n", n_in, out_size, ws_size, (size_t)WS_END); grid = -1; return; }
        int dev = 0, cus = 0, per_cu = 0;
        if (hipGetDevice(&dev) != hipSuccess || hipDeviceGetAttribute(&cus, hipDeviceAttributeMultiprocessorCount, dev) != hipSuccess) { grid = -1; return; }
        if (hipFuncSetAttribute((const void*)mk_fwd, hipFuncAttributeMaxDynamicSharedMemorySize, LDS_BYTES) != hipSuccess) { fprintf(stderr, "kernel_launch: hipFuncSetAttribute failed\n"); grid = -1; return; }
        if (hipOccupancyMaxActiveBlocksPerMultiprocessor(&per_cu, (const void*)mk_fwd, NTHREADS, LDS_BYTES) != hipSuccess || per_cu < 1) { fprintf(stderr, "kernel_launch: occupancy query %d\n", per_cu); (void)hipGetLastError(); grid = -1; return; }
        grid = cus;
    }
    if (grid < 0) return;
    if (hipMemsetAsync((char*)d_ws + WS_CTL, 0, WS_ZERO_BYTES, stream) != hipSuccess) return;
    Args a{};
    for (int i = 0; i < 21; ++i) a.in[i] = (const float*)d_in[i];
    a.out = (float*)d_out; a.ws = (unsigned char*)d_ws; a.ph_lo = 0; a.ph_hi = NPHASE;
    void* args[] = {&a};
    hipError_t e = hipLaunchCooperativeKernel((const void*)mk_fwd, dim3(grid), dim3(NTHREADS), args, LDS_BYTES, stream);
    if (e != hipSuccess) fprintf(stderr, "cooperative launch failed: %s (grid %d)\n", hipGetErrorString(e), grid);
}
```

```cpp
#include <hip/hip_runtime.h>
#include <hip/hip_cooperative_groups.h>
#include <cstdio>
#include <cstdint>
namespace cg = cooperative_groups;

#define LAS __attribute__((address_space(3)))
typedef unsigned short bf16_t;
typedef short bf16x8 __attribute__((ext_vector_type(8)));
typedef short s16x4 __attribute__((ext_vector_type(4)));
typedef float f32x4 __attribute__((ext_vector_type(4)));
typedef float f32x2 __attribute__((ext_vector_type(2)));
typedef float f32x16 __attribute__((ext_vector_type(16)));
typedef unsigned u32x4 __attribute__((ext_vector_type(4)));
typedef unsigned u32x2 __attribute__((ext_vector_type(2)));
typedef __bf16 bf16x2_t __attribute__((ext_vector_type(2)));
typedef _Float16 f16x2_t __attribute__((ext_vector_type(2)));
typedef LAS unsigned char* lptr;
#define GAS __attribute__((address_space(1)))
typedef const float* cfp_t;
struct inptr_t {
    __attribute__((address_space(4))) const cfp_t* p;
    __device__ __forceinline__ const float* operator[](int i) const { return (const float*)(const GAS float*)p[i]; }
};

constexpr int DM = 1024, M_CTX = 8192, M_TOT = 16384, NCOND = 5, DEPTH = 4;
constexpr int A_IN = 5120, QKV_N = 1536, D_FF = 2816, GU_N = 5632;
constexpr float EPS = 1e-6f;
constexpr float LOG2E = 1.4426950408889634f;
constexpr int NTHREADS = 512, NWAVES = 8;

constexpr size_t OUT_Y = 0, OUT_CK = 16777216, OUT_CV = 20971520, OUT_ST = 25165824, OUT_TOTAL = 41943040;

constexpr size_t MiB = 1u << 20;
constexpr size_t WS_CTL = 0;
constexpr size_t WS_MOD = 1 * MiB;
constexpr size_t WS_SS = WS_MOD + 512 * 1024;
constexpr size_t WS_ZERO_BYTES = 2 * MiB + 256 * 1024;
constexpr size_t WS_BIAS_IN = 3 * MiB;
constexpr size_t WS_BIAS_QKV = WS_BIAS_IN + 2 * 5 * 5120 * 4;
constexpr size_t WS_BIAS_GU = WS_BIAS_QKV + 2 * 5 * 1536 * 4;
constexpr size_t WS_LB = WS_BIAS_GU + 4 * 5 * 5632 * 4;
constexpr size_t WS_ROPE = WS_LB + 4 * 1024 * 4;
constexpr size_t WS_TAB_END = WS_ROPE + 2 * 2 * 64 * 32 * 4;
static_assert(WS_TAB_END <= 4 * MiB, "tables");
constexpr size_t WS_W_IN = 4 * MiB;
constexpr size_t WS_W_OUTA = WS_W_IN + (size_t)2 * 5120 * 1024 * 2;
constexpr size_t WS_W_QKV = WS_W_OUTA + (size_t)2 * 1024 * 1024 * 2;
constexpr size_t WS_W_OUTB = WS_W_QKV + (size_t)2 * 1536 * 1024 * 2;
constexpr size_t WS_W_GU = WS_W_OUTB + (size_t)2 * 1024 * 1024 * 2;
constexpr size_t WS_W_DN = WS_W_GU + (size_t)4 * 5632 * 1024 * 2;
constexpr size_t WS_CK = WS_W_DN + (size_t)4 * 1024 * 2816 * 2;
constexpr size_t WS_CVT = WS_CK + (size_t)4 * 2 * 512 * 256 * 2;
constexpr size_t WS_XA = WS_CVT + (size_t)4 * 2 * 512 * 256 * 2;
constexpr size_t WS_A2 = WS_XA + (size_t)M_TOT * DM * 2;
constexpr size_t WS_R = WS_A2 + (size_t)M_TOT * DM * 2;
constexpr size_t ACT = (size_t)M_TOT * DM * 2;
constexpr size_t WS_HQ = WS_R, WS_HKF = WS_R + ACT, WS_HKB = WS_R + 2 * ACT, WS_HV = WS_R + 3 * ACT, WS_HGF = WS_R + 4 * ACT, WS_HGB = WS_R + 5 * ACT;
constexpr size_t WS_H = WS_R;
constexpr size_t WS_AQ = WS_R, WS_AK = WS_R + ACT, WS_AVT = WS_AK + (size_t)M_TOT * 256 * 2;
constexpr size_t WS_OFW = WS_R + 6 * ACT;
constexpr size_t WS_XB = WS_OFW + ACT;
constexpr size_t WS_END = WS_XB + ACT;

__device__ __forceinline__ unsigned pk_bf16(float lo, float hi) { f32x2 v = {lo, hi}; bf16x2_t b = __builtin_convertvector(v, bf16x2_t); return __builtin_bit_cast(unsigned, b); }
__device__ __forceinline__ bf16_t to_bf16(float x) { return (bf16_t)(pk_bf16(x, 0.f) & 0xffffu); }
__device__ __forceinline__ float bf_lo(unsigned u) { return __uint_as_float(u << 16); }
__device__ __forceinline__ float bf_hi(unsigned u) { return __uint_as_float(u & 0xffff0000u); }
__device__ __forceinline__ unsigned pk_f16(float lo, float hi) { f32x2 v = {lo, hi}; f16x2_t h = __builtin_convertvector(v, f16x2_t); return __builtin_bit_cast(unsigned, h); }
__device__ __forceinline__ f32x2 unpk_f16(unsigned u) { f16x2_t h = __builtin_bit_cast(f16x2_t, u); return __builtin_convertvector(h, f32x2); }
__device__ __forceinline__ float fast_exp2(float x) { return __builtin_amdgcn_exp2f(x); }
__device__ __forceinline__ float fast_rcp(float x) { return __builtin_amdgcn_rcpf(x); }
__device__ __forceinline__ float silu_f(float z) { z = fminf(fmaxf(z, -60.f), 60.f); return z * fast_rcp(1.f + fast_exp2(-z * LOG2E)); }
__device__ __forceinline__ float wave_sum(float v) {
#pragma unroll
    for (int o = 1; o < 64; o <<= 1) v += __shfl_xor(v, o);
    return v;
}
typedef int i32x4 __attribute__((ext_vector_type(4)));
constexpr float MOD_SCALE = 16777216.f, MOD_INV = 1.f / 16777216.f;
constexpr float SS_SCALE = 4096.f, SS_INV = 1.f / 4096.f;
__device__ __forceinline__ f32x4 modv4(const int* p) { const i32x4 v = *(const i32x4*)p; return (f32x4){(float)v.x * MOD_INV, (float)v.y * MOD_INV, (float)v.z * MOD_INV, (float)v.w * MOD_INV}; }
__device__ __forceinline__ float ss_rstd(const unsigned* ss, int row) { return rsqrtf((float)ss[row] * (SS_INV / DM) + EPS); }
__device__ __forceinline__ int cond_of_tile(int pm) { return pm < 32 ? 0 : 1 + ((pm - 32) >> 3); }
__device__ __forceinline__ int cond_of_row(int row) { return row < M_CTX ? 0 : 1 + ((row - M_CTX) >> 11); }

#define XB_TMO      128
#define XB_XCNT(j)  (256  + 64 * (j))
#define XB_XSUB(j)  (1280 + 64 * (j))
#define XB_XGEN(j)  (2304 + 64 * (j))
#define XB_TOP      3328
#define XB_TOPGEN   3392
#define XCD_BAR_WORDS 3456
#define XB_SPIN_CAP (1u << 20)
__device__ __forceinline__ unsigned xb_ld(unsigned* p)              { return __hip_atomic_load(p, __ATOMIC_RELAXED, __HIP_MEMORY_SCOPE_AGENT); }
__device__ __forceinline__ unsigned xb_add(unsigned* p, unsigned v) { return __hip_atomic_fetch_add(p, v, __ATOMIC_RELAXED, __HIP_MEMORY_SCOPE_AGENT); }
__device__ __forceinline__ unsigned xb_xcc_id() { return (unsigned)__builtin_amdgcn_s_getreg((3 << 11) | 20) & 0xFu; }
#define XB_SPIN(cond, bar) do { unsigned _sp = 0; while (cond) { __builtin_amdgcn_s_sleep(1); \
    if ((++_sp & 255u) == 0u) { if (xb_ld(&(bar)[XB_TMO])) break; if (_sp > XB_SPIN_CAP) { atomicAdd(&(bar)[XB_TMO], 1u); break; } } } } while (0)
struct XcdBarrier { unsigned* bar; unsigned x; volatile LAS unsigned* st; };
__device__ __forceinline__ XcdBarrier xcd_barrier_post(unsigned* bar, volatile LAS unsigned* st) {
    XcdBarrier b; b.bar = bar; b.x = xb_xcc_id(); b.st = st;
    if (threadIdx.x == 0) (void)xb_add(&bar[XB_XCNT(b.x)], 1u);
    return b;
}
__device__ __forceinline__ void xcd_barrier_complete(unsigned* bar, unsigned x, unsigned& nloc, unsigned& nx) {
    const unsigned G = gridDim.x * gridDim.y * gridDim.z;
    unsigned sum, cnt, mine, sp = 0u;
    for (;;) {
        sum = 0u; cnt = 0u; mine = 0u;
#pragma unroll
        for (unsigned j = 0; j < 16; ++j) { const unsigned c = xb_ld(&bar[XB_XCNT(j)]); sum += c; cnt += (c > 0u) ? 1u : 0u; mine = (j == x) ? c : mine; }
        if (sum == G) break;
        __builtin_amdgcn_s_sleep(1);
        if ((++sp & 255u) == 0u) { if (xb_ld(&bar[XB_TMO])) break; if (sp > XB_SPIN_CAP) { atomicAdd(&bar[XB_TMO], 1u); break; } }
    }
    nloc = mine > 0u ? mine : 1u; nx = cnt > 0u ? cnt : 1u;
}
__device__ __forceinline__ void xcd_barrier(const XcdBarrier& b) {
    asm volatile("s_waitcnt vmcnt(0)" ::: "memory");
    __syncthreads();
    if (threadIdx.x == 0) {
        unsigned* bar = b.bar;
        __builtin_amdgcn_s_waitcnt(0);
        unsigned nloc = b.st[0], nx = b.st[1];
        if (nloc == 0u) { xcd_barrier_complete(bar, b.x, nloc, nx); b.st[0] = nloc; b.st[1] = nx; }
        const unsigned old = xb_add(&bar[XB_XSUB(b.x)], 1u);
        const unsigned gen = old / nloc;
        if (old + 1u == (gen + 1u) * nloc) {
            __builtin_amdgcn_fence(__ATOMIC_RELEASE, "agent");
            asm volatile("s_waitcnt vmcnt(0)" ::: "memory");
            const unsigned og = xb_add(&bar[XB_TOP], 1u);
            const unsigned tg = og / nx;
            if (og + 1u == (tg + 1u) * nx) xb_add(&bar[XB_TOPGEN], 1u);
            else XB_SPIN(xb_ld(&bar[XB_TOPGEN]) == tg, bar);
            __builtin_amdgcn_fence(__ATOMIC_ACQUIRE, "agent");
            xb_add(&bar[XB_XGEN(b.x)], 1u);
            asm volatile("s_waitcnt vmcnt(0)" ::: "memory");
        } else {
            XB_SPIN(xb_ld(&bar[XB_XGEN(b.x)]) == gen, bar);
            __builtin_amdgcn_fence(__ATOMIC_ACQUIRE, "agent");
            asm volatile("s_waitcnt vmcnt(0)" ::: "memory");
        }
    }
    __syncthreads();
}

namespace pg8 {
constexpr int BM = 256, BK = 64, HALF = 128, HTB = HALF * BK * 2, STAGE_BYTES = 8 * HTB, NXCD = 8, WGM = 8;
__host__ __device__ __forceinline__ int lds_byte(int r, int c) { const int st = (r >> 4) * 2 + (c >> 5), rr = r & 15, cc = c & 31, ob = rr * 64 + cc * 2; return st * 1024 + (ob ^ (((ob >> 9) & 1) << 5)); }
__host__ __device__ __forceinline__ void stage_rc(int b, int& R, int& C) { const int st = b / 1024, sb = b % 1024, swz = sb ^ (((sb >> 9) & 1) << 5); R = (st >> 1) * 16 + swz / 64; C = (st & 1) * 32 + (swz % 64) / 2; }
__host__ __device__ __forceinline__ int perm32(int rho) { const int n = rho >> 4, i = rho & 15; return 8 * (i >> 2) + 4 * n + (i & 3); }
struct Unit { int pm, pn, half; };
struct Gemm { const bf16_t* A; const bf16_t* Bt; int M, N, K; };
struct StaticOrder {
    int nM, nN, nwg, G, c;
    __host__ __device__ void init(int M, int N, int G_, int c_) { nM = M / BM; nN = N / BM; nwg = nM * nN; G = G_; c = c_; }
    __host__ __device__ void map(int L, Unit& u) const {
        int wgid = L; { const int q = nwg / NXCD, r = nwg % NXCD, xcd = wgid % NXCD, off = wgid / NXCD; wgid = (xcd < r ? xcd * (q + 1) : r * (q + 1) + (xcd - r) * q) + off; }
        const int nig = WGM * nN, gid = wgid / nig, fm = gid * WGM, gsz = (nM - fm) < WGM ? (nM - fm) : WGM;
        u.pm = fm + ((wgid % nig) % gsz); u.pn = (wgid % nig) / gsz; u.half = 0;
    }
    __host__ __device__ bool next(int i, Unit& u) const {
        const long L = (long)i * G + c; if (L >= nwg) return false;
        map((int)L, u); return true;
    }
};
struct HalfTailOrder : StaticOrder {
    __host__ __device__ bool next(int i, Unit& u) const {
        const int nfull = (nwg / G) * G;
        const long L = (long)i * G + c;
        if (L < nfull) { map((int)L, u); return true; }
        if (i != nwg / G || c >= 2 * (nwg - nfull)) return false;
        map(nfull + (c >> 1), u); u.half = 1 + (c & 1); return true;
    }
};
template <class Epi, class Sched = StaticOrder, bool HT = false>
__device__ __forceinline__ void gemm_phase(lptr lds, const int tid, const Gemm g, const Sched& S, const Epi& E) {
    const int wid = __builtin_amdgcn_readfirstlane(tid >> 6), lane = tid & 63, wr = wid >> 2, wc = wid & 3, fr = lane & 15, fq = lane >> 4;
    const int K = g.K, nt = K / BK;
    unsigned voffA[2], voffB[2];
#pragma unroll
    for (int i = 0; i < 2; ++i) { int R, C; stage_rc(tid * 16 + i * 8192, R, C); const int Rb = (R & ~31) + perm32(R & 31);
        voffA[i] = (unsigned)(R * K + C) * 2u; voffB[i] = (unsigned)(Rb * K + C) * 2u; }
    const size_t kstep = (size_t)(BK * 2);
    const size_t hstep = (size_t)HALF * K * 2;
    const size_t tstep = 2 * hstep;
    const unsigned ldsw = (unsigned)wid * 1024u;
    const int aoff = lds_byte(wr * 64 + fr, fq * 8), boff = lds_byte(wc * 32 + fr, fq * 8);
#define PG8_SA(b, h) (((b) * 2 + (h)) * HTB)
#define PG8_SB(b, h) ((4 + (b) * 2 + (h)) * HTB)
#define PG8_STAGE(bufoff, gbase, voff) do { _Pragma("unroll") for (int _i = 0; _i < 2; ++_i) \
        __builtin_amdgcn_global_load_lds((const unsigned*)((const char*)(gbase) + (voff)[_i]), (LAS unsigned*)(lds + (bufoff) + ldsw + _i * 8192), 16, 0, 0); } while (0)
#define PG8_LDA(dst, b, h) do { _Pragma("unroll") for (int m = 0; m < 4; ++m) _Pragma("unroll") for (int k = 0; k < 2; ++k) dst[m][k] = *(const LAS bf16x8*)(lds + PG8_SA(b, h) + aoff + m * 2048 + k * 1024); } while (0)
#define PG8_LDB(dst, b, h) do { _Pragma("unroll") for (int n = 0; n < 2; ++n) _Pragma("unroll") for (int k = 0; k < 2; ++k) dst[n][k] = *(const LAS bf16x8*)(lds + PG8_SB(b, h) + boff + n * 2048 + k * 1024); } while (0)
#define PG8_MMA(ai, bj, At, Bt) do { __builtin_amdgcn_s_setprio(1); _Pragma("unroll") for (int m = 0; m < 4; ++m) _Pragma("unroll") for (int n = 0; n < 2; ++n) _Pragma("unroll") for (int k = 0; k < 2; ++k) \
        acc[ai][bj][m][n] = __builtin_amdgcn_mfma_f32_16x16x32_bf16(Bt[n][k], At[m][k], acc[ai][bj][m][n], 0, 0, 0); __builtin_amdgcn_s_setprio(0); } while (0)
#define PG8_WAIT_V(n) asm volatile("s_waitcnt vmcnt(" #n ")" ::: "memory")
#define PG8_WAIT_L(n) asm volatile("s_waitcnt lgkmcnt(" #n ")" ::: "memory")
#define PG8_BAR __builtin_amdgcn_s_barrier()
#define PG8_SCHED __builtin_amdgcn_sched_barrier(0)
    Unit cur, nxt; int ui = 0;
    if (!S.next(0, cur)) return;
    f32x4 acc[2][2][4][2];
#pragma unroll
    for (int a = 0; a < 2; ++a)
#pragma unroll
        for (int b = 0; b < 2; ++b)
#pragma unroll
            for (int m = 0; m < 4; ++m)
#pragma unroll
                for (int n = 0; n < 2; ++n) acc[a][b][m][n] = (f32x4){0.f, 0.f, 0.f, 0.f};
    bf16x8 At[4][2], B0[2][2], B1[2][2];
    const char* cA = (const char*)g.A + (size_t)cur.pm * tstep + ((HT && cur.half == 2) ? hstep : 0); const char* cB = (const char*)g.Bt + (size_t)cur.pn * tstep;
    unsigned cH = (HT && cur.half) ? 0u : (unsigned)hstep; if constexpr (HT) cH = __builtin_amdgcn_readfirstlane(cH);
    PG8_STAGE(PG8_SB(0, 0), cB, voffB); PG8_STAGE(PG8_SB(0, 1), cB + hstep, voffB); PG8_STAGE(PG8_SA(0, 0), cA, voffA); PG8_STAGE(PG8_SA(0, 1), cA + cH, voffA);
    if (wr == 1) PG8_BAR;
    PG8_WAIT_V(2); PG8_BAR;
    PG8_STAGE(PG8_SB(1, 0), cB + kstep, voffB); PG8_STAGE(PG8_SA(1, 0), cA + kstep, voffA); PG8_STAGE(PG8_SB(1, 1), cB + hstep + kstep, voffB);
    PG8_WAIT_V(6); PG8_BAR;
    for (;;) {
        const bool has_next = S.next(ui + 1, nxt);
        const char* nA = has_next ? (const char*)g.A + (size_t)nxt.pm * tstep + ((HT && nxt.half == 2) ? hstep : 0) : cA; const char* nB = has_next ? (const char*)g.Bt + (size_t)nxt.pn * tstep : cB;
        unsigned nH = has_next ? ((HT && nxt.half) ? 0u : (unsigned)hstep) : cH; int skip1 = (HT && cur.half != 0) ? 1 : 0;
        if constexpr (HT) { nH = __builtin_amdgcn_readfirstlane(nH); skip1 = __builtin_amdgcn_readfirstlane(skip1); }
        if (HT && skip1) {
        for (int t = 0; t < nt; t += 2) {
            const bool last = (t == nt - 2);
            const char* a1 = cA + (size_t)(t + 1) * kstep;
            const char* a2 = last ? nA : cA + (size_t)(t + 2) * kstep; const char* b2 = last ? nB : cB + (size_t)(t + 2) * kstep;
            const char* a3 = a2 + kstep; const char* b3 = b2 + kstep;
            const unsigned h2 = last ? nH : cH;
            PG8_LDB(B0, 0, 0); PG8_LDB(B1, 0, 1); PG8_SCHED; PG8_LDA(At, 0, 0); PG8_STAGE(PG8_SA(1, 1), a1 + cH, voffA);
            PG8_WAIT_V(8); PG8_WAIT_L(0); PG8_BAR; PG8_MMA(0, 0, At, B0); PG8_MMA(0, 1, At, B1); PG8_BAR; PG8_SCHED;
            PG8_LDA(At, 0, 1); PG8_STAGE(PG8_SB(0, 0), b2, voffB); PG8_STAGE(PG8_SB(0, 1), b2 + hstep, voffB); PG8_STAGE(PG8_SA(0, 0), a2, voffA);
            PG8_WAIT_V(8); PG8_WAIT_L(0); PG8_BAR;  PG8_BAR; PG8_SCHED;
            PG8_LDB(B0, 1, 0); PG8_LDB(B1, 1, 1); PG8_SCHED; PG8_LDA(At, 1, 0); PG8_STAGE(PG8_SA(0, 1), a2 + h2, voffA);
            PG8_WAIT_V(8); PG8_WAIT_L(0); PG8_BAR; PG8_MMA(0, 0, At, B0); PG8_MMA(0, 1, At, B1); PG8_BAR; PG8_SCHED;
            PG8_LDA(At, 1, 1); PG8_STAGE(PG8_SB(1, 0), b3, voffB); PG8_STAGE(PG8_SB(1, 1), b3 + hstep, voffB); PG8_STAGE(PG8_SA(1, 0), a3, voffA);
            PG8_WAIT_V(8); PG8_WAIT_L(0); PG8_BAR;  PG8_BAR; PG8_SCHED;
        }
        } else {
        for (int t = 0; t < nt; t += 2) {
            const bool last = (t == nt - 2);
            const char* a1 = cA + (size_t)(t + 1) * kstep;
            const char* a2 = last ? nA : cA + (size_t)(t + 2) * kstep; const char* b2 = last ? nB : cB + (size_t)(t + 2) * kstep;
            const char* a3 = a2 + kstep; const char* b3 = b2 + kstep;
            const unsigned h2 = last ? nH : cH;
            PG8_LDB(B0, 0, 0); PG8_LDB(B1, 0, 1); PG8_SCHED; PG8_LDA(At, 0, 0); PG8_STAGE(PG8_SA(1, 1), a1 + cH, voffA);
            PG8_WAIT_V(8); PG8_WAIT_L(0); PG8_BAR; PG8_MMA(0, 0, At, B0); PG8_MMA(0, 1, At, B1); PG8_BAR; PG8_SCHED;
            PG8_LDA(At, 0, 1); PG8_STAGE(PG8_SB(0, 0), b2, voffB); PG8_STAGE(PG8_SB(0, 1), b2 + hstep, voffB); PG8_STAGE(PG8_SA(0, 0), a2, voffA);
            PG8_WAIT_V(8); PG8_WAIT_L(0); PG8_BAR; PG8_MMA(1, 0, At, B0); PG8_MMA(1, 1, At, B1); PG8_BAR; PG8_SCHED;
            PG8_LDB(B0, 1, 0); PG8_LDB(B1, 1, 1); PG8_SCHED; PG8_LDA(At, 1, 0); PG8_STAGE(PG8_SA(0, 1), a2 + h2, voffA);
            PG8_WAIT_V(8); PG8_WAIT_L(0); PG8_BAR; PG8_MMA(0, 0, At, B0); PG8_MMA(0, 1, At, B1); PG8_BAR; PG8_SCHED;
            PG8_LDA(At, 1, 1); PG8_STAGE(PG8_SB(1, 0), b3, voffB); PG8_STAGE(PG8_SB(1, 1), b3 + hstep, voffB); PG8_STAGE(PG8_SA(1, 0), a3, voffA);
            PG8_WAIT_V(8); PG8_WAIT_L(0); PG8_BAR; PG8_MMA(1, 0, At, B0); PG8_MMA(1, 1, At, B1); PG8_BAR; PG8_SCHED;
        }
        }
        if (wr == 0) PG8_BAR;
        E(acc, cur, wr, wc, fr, fq);
        if (!has_next) break;
#pragma unroll
        for (int a = 0; a < 2; ++a)
#pragma unroll
            for (int b = 0; b < 2; ++b)
#pragma unroll
                for (int m = 0; m < 4; ++m)
#pragma unroll
                    for (int n = 0; n < 2; ++n) acc[a][b][m][n] = (f32x4){0.f, 0.f, 0.f, 0.f};
        cur = nxt; cA = nA; cB = nB; cH = nH; ++ui;
        if (wr == 1) PG8_BAR;
    }
    PG8_WAIT_V(0);
    PG8_BAR;
#undef PG8_SA
#undef PG8_SB
#undef PG8_STAGE
#undef PG8_LDA
#undef PG8_LDB
#undef PG8_MMA
#undef PG8_WAIT_V
#undef PG8_WAIT_L
#undef PG8_BAR
#undef PG8_SCHED
}
}
typedef f32x4 AccT[2][2][4][2];

struct EpiIn {
    unsigned char* ws; int l;
    __device__ __forceinline__ void operator()(const AccT& acc, const pg8::Unit& u, int wr, int wc, int fr, int fq) const {
        const int j = l >> 1;
        const unsigned* ss = (const unsigned*)(ws + WS_SS) + (size_t)(2 * l) * M_TOT; const float* bias = (const float*)(ws + WS_BIAS_IN) + (size_t)j * NCOND * A_IN; const float* lb = (const float*)(ws + WS_LB) + (size_t)j * 2048;
        bf16_t* Q = (bf16_t*)(ws + WS_HQ); bf16_t* KF = (bf16_t*)(ws + WS_HKF); bf16_t* KB = (bf16_t*)(ws + WS_HKB); bf16_t* V = (bf16_t*)(ws + WS_HV); bf16_t* SG = (bf16_t*)(ws + WS_A2);
        unsigned short* GF = (unsigned short*)(ws + WS_HGF); unsigned short* GB = (unsigned short*)(ws + WS_HGB);
        const int cond = cond_of_tile(u.pm), type = u.pn >> 2, chb = (u.pn & 3) * 256 + wc * 32 + 8 * fq;
        const float* bp = bias + (size_t)cond * A_IN + type * 1024;
        float rs[8]; f32x4 bv[2][2], lv[2][2];
#pragma unroll
        for (int i = 0; i < 8; ++i) rs[i] = ss_rstd(ss, u.pm * 256 + (i >> 2) * 128 + wr * 64 + (i & 3) * 16 + fr);
#pragma unroll
        for (int bj = 0; bj < 2; ++bj) { bv[bj][0] = *(const f32x4*)(bp + chb + bj * 128); bv[bj][1] = *(const f32x4*)(bp + chb + bj * 128 + 4);
            const float* lp = lb + ((type == 2) ? 1024 : 0) + chb + bj * 128; lv[bj][0] = *(const f32x4*)lp; lv[bj][1] = *(const f32x4*)(lp + 4); }
        asm volatile("" ::: "memory");
        if (type == 1 || type == 2) {
#pragma unroll
            for (int i = 0; i < 8; ++i) rs[i] *= -LOG2E;
#pragma unroll
            for (int bj = 0; bj < 2; ++bj) { bv[bj][0] = bv[bj][0] * -LOG2E; bv[bj][1] = bv[bj][1] * -LOG2E; }
        }
#pragma unroll
        for (int ai = 0; ai < 2; ++ai)
#pragma unroll
            for (int m = 0; m < 4; ++m) {
                const int row = u.pm * 256 + ai * 128 + wr * 64 + m * 16 + fr;
                const float rstd = rs[ai * 4 + m];
#pragma unroll
                for (int bj = 0; bj < 2; ++bj) {
                    const int ch = chb + bj * 128;
                    const f32x4 b0 = bv[bj][0], b1 = bv[bj][1];
                    float z[8];
#pragma unroll
                    for (int e = 0; e < 4; ++e) { z[e] = acc[ai][bj][m][0][e] * rstd + b0[e]; z[4 + e] = acc[ai][bj][m][1][e] * rstd + b1[e]; }
                    const size_t o = (size_t)row * DM + ch;
                    if (type == 0 || type == 4) {
                        u32x4 w; w.x = pk_bf16(silu_f(z[0]), silu_f(z[1])); w.y = pk_bf16(silu_f(z[2]), silu_f(z[3])); w.z = pk_bf16(silu_f(z[4]), silu_f(z[5])); w.w = pk_bf16(silu_f(z[6]), silu_f(z[7]));
                        *(u32x4*)((type == 0 ? Q : SG) + o) = w;
                    } else if (type == 3) {
                        u32x4 w; w.x = pk_bf16(z[0], z[1]); w.y = pk_bf16(z[2], z[3]); w.z = pk_bf16(z[4], z[5]); w.w = pk_bf16(z[6], z[7]);
                        *(u32x4*)(V + o) = w;
                    } else {
                        const f32x4 l0 = lv[bj][0], l1 = lv[bj][1];
                        float lg[8];
#pragma unroll
                        for (int e = 0; e < 8; ++e) {
                            const float lbv = e < 4 ? l0[e] : l1[e - 4];
                            const float sg = fast_rcp(1.f + fast_exp2(fminf(z[e], 57.7f)));
                            lg[e] = __builtin_amdgcn_logf(lbv + (1.f - lbv) * sg);
                        }
                        u32x4 h; h.x = pk_f16(lg[0], lg[1]); h.y = pk_f16(lg[2], lg[3]); h.z = pk_f16(lg[4], lg[5]); h.w = pk_f16(lg[6], lg[7]);
                        *(u32x4*)((type == 1 ? GF : GB) + o) = h;
                    }
                }
            }
    }
};

struct EpiQkv {
    unsigned char* ws; float* out; int l;
    __device__ __forceinline__ void operator()(const AccT& acc, const pg8::Unit& u, int wr, int wc, int fr, int fq) const {
        const int roff = u.half == 2 ? 128 : 0; const bool hu = u.half != 0;
        const int j = l >> 1;
        const unsigned* ss = (const unsigned*)(ws + WS_SS) + (size_t)(2 * l) * M_TOT; const float* bias = (const float*)(ws + WS_BIAS_QKV) + (size_t)j * NCOND * QKV_N; const float* rope = (const float*)(ws + WS_ROPE);
        bf16_t* Qa = (bf16_t*)(ws + WS_AQ); bf16_t* Ka = (bf16_t*)(ws + WS_AK); bf16_t* VaT = (bf16_t*)(ws + WS_AVT); float* outK = out + OUT_CK; float* outV = out + OUT_CV;
        const int cond = cond_of_tile(u.pm);
        const bool lat = u.pm >= 32;
        const float* bp = bias + (size_t)cond * QKV_N + u.pn * 256;
        const float qscale = 0.08838834764831845f * LOG2E;
        float rs[8]; f32x4 bv[2][2];
#pragma unroll
        for (int i = 0; i < 8; ++i) rs[i] = ss_rstd(ss, u.pm * 256 + roff + (hu ? 0 : (i >> 2)) * 128 + wr * 64 + (i & 3) * 16 + fr);
#pragma unroll
        for (int bj = 0; bj < 2; ++bj) { const int cl = bj * 128 + wc * 32 + 8 * fq; bv[bj][0] = *(const f32x4*)(bp + cl); bv[bj][1] = *(const f32x4*)(bp + cl + 4); }
        asm volatile("" ::: "memory");
#pragma unroll
        for (int ai = 0; ai < 2; ++ai)
#pragma unroll
            for (int m = 0; m < 4; ++m) {
                if (hu && ai == 1) continue;
                const int row = u.pm * 256 + roff + ai * 128 + wr * 64 + m * 16 + fr;
                const float rstd = rs[ai * 4 + m];
                const int tl = (row - M_CTX) & 2047;
                f32x4 csv[2], snv[2];
                if (lat && u.pn < 5) {
#pragma unroll
                    for (int bj = 0; bj < 2; ++bj) { const int hl = (bj * 128 + wc * 32 + 8 * fq) & 127, ax = hl >> 6, j0 = (hl & 63) >> 1; const int pos = ax ? (tl & 63) : (tl >> 6);
                        const float* cp = rope + (ax * 64 + pos) * 32 + j0; csv[bj] = *(const f32x4*)cp; snv[bj] = *(const f32x4*)(cp + 2 * 64 * 32); }
                    asm volatile("" ::: "memory");
                }
#pragma unroll
                for (int bj = 0; bj < 2; ++bj) {
                    const int cl = bj * 128 + wc * 32 + 8 * fq;
                    const f32x4 b0 = bv[bj][0], b1 = bv[bj][1];
                    float z[8];
#pragma unroll
                    for (int e = 0; e < 4; ++e) { z[e] = acc[ai][bj][m][0][e] * rstd + b0[e]; z[4 + e] = acc[ai][bj][m][1][e] * rstd + b1[e]; }
                    if (u.pn < 5) {
                        const int hl = cl & 127, ax = hl >> 6, j0 = (hl & 63) >> 1;
                        if (u.pn == 4 && !lat) {
                            const int b = row >> 8, t = row & 255, kvh = cl >> 7;
                            float* op = outK + ((size_t)((b * 2 + j) * 256 + t) * 2 + kvh) * 128 + ax * 64 + j0;
                            *(f32x4*)op = (f32x4){z[0], z[2], z[4], z[6]};
                            *(f32x4*)(op + 32) = (f32x4){z[1], z[3], z[5], z[7]};
                        }
                        if (lat) {
                            const f32x4 cs = csv[bj], sn = snv[bj];
#pragma unroll
                            for (int e = 0; e < 4; ++e) { const float x1 = z[2 * e], x2 = z[2 * e + 1]; z[2 * e] = x1 * cs[e] - x2 * sn[e]; z[2 * e + 1] = x1 * sn[e] + x2 * cs[e]; }
                        }
                        if (u.pn < 4) {
#pragma unroll
                            for (int e = 0; e < 8; ++e) z[e] *= qscale;
                            u32x4 w; w.x = pk_bf16(z[0], z[1]); w.y = pk_bf16(z[2], z[3]); w.z = pk_bf16(z[4], z[5]); w.w = pk_bf16(z[6], z[7]);
                            *(u32x4*)(Qa + (size_t)row * DM + u.pn * 256 + cl) = w;
                        } else {
                            u32x4 w; w.x = pk_bf16(z[0], z[1]); w.y = pk_bf16(z[2], z[3]); w.z = pk_bf16(z[4], z[5]); w.w = pk_bf16(z[6], z[7]);
                            *(u32x4*)(Ka + (size_t)row * 256 + cl) = w;
                        }
                    } else {
                        const int kvh = cl >> 7, d0 = cl & 127;
                        size_t vb; int T;
                        if (!lat) { const int b = row >> 8, t = row & 255; T = 256; vb = ((size_t)(b * 2 + kvh) * 128 + d0) * 256 + t;
                            float* op = outV + ((size_t)((b * 2 + j) * 256 + t) * 2 + kvh) * 128 + d0;
                            *(f32x4*)op = (f32x4){z[0], z[1], z[2], z[3]}; *(f32x4*)(op + 4) = (f32x4){z[4], z[5], z[6], z[7]};
                        } else { const int b = (row - M_CTX) >> 11; T = 2048; vb = (size_t)2097152 + ((size_t)(b * 2 + kvh) * 128 + d0) * 2048 + tl; }
#pragma unroll
                        for (int e = 0; e < 8; ++e) VaT[vb + (size_t)e * T] = to_bf16(z[e]);
                    }
                }
            }
    }
};

struct EpiRes {
    unsigned char* ws; float* x; inptr_t in; int l; int down; lptr lds;
    __device__ __forceinline__ void operator()(const AccT& acc, const pg8::Unit& u, int wr, int wc, int fr, int fq) const {
        const int* mod = (const int*)(ws + WS_MOD);
        const bool lastl = down && l == 3;
        const int* gate = mod + (size_t)l * 6144 + (down ? 5120 : 2048);
        const float* nw = down ? in[9] + (size_t)(l + 1) * DM : in[10] + (size_t)l * DM;
        const int* sc = lastl ? nullptr : (down ? mod + (size_t)(l + 1) * 6144 + 1024 : mod + (size_t)l * 6144 + 4096);
        unsigned* ssout = (unsigned*)(ws + WS_SS) + (size_t)(2 * l + 1 + down) * M_TOT;
        bf16_t* XA = lastl ? nullptr : (bf16_t*)(ws + WS_XA);
        const int cond = cond_of_tile(u.pm);
        const int* gp = gate + (size_t)cond * (4 * 6144); const int* sp = sc ? sc + (size_t)cond * (4 * 6144) : nullptr;
        f32x4 gv[2][2], nsv[2][2];
#pragma unroll
        for (int bj = 0; bj < 2; ++bj) { const int col = u.pn * 256 + bj * 128 + wc * 32 + 8 * fq;
            gv[bj][0] = modv4(gp + col); gv[bj][1] = modv4(gp + col + 4);
            if (XA) { nsv[bj][0] = *(const f32x4*)(nw + col) * (modv4(sp + col) + 1.f); nsv[bj][1] = *(const f32x4*)(nw + col + 4) * (modv4(sp + col + 4) + 1.f); } }
#pragma unroll
        for (int ai = 0; ai < 2; ++ai) {
            u32x4 xw[4][2];
#pragma unroll
            for (int m = 0; m < 4; ++m) {
                if (!(l == 0 && !down) && (m & 1) == 0) {
#pragma unroll
                    for (int mm = m; mm < m + 2; ++mm)
#pragma unroll
                        for (int bj = 0; bj < 2; ++bj) { const int row2 = u.pm * 256 + ai * 128 + wr * 64 + mm * 16 + fr, col = u.pn * 256 + bj * 128 + wc * 32 + 8 * fq;
                            xw[mm][bj] = *(const u32x4*)((const bf16_t*)(ws + WS_XB) + (size_t)row2 * DM + col); }
                    asm volatile("" ::: "memory");
                }
                const int row = u.pm * 256 + ai * 128 + wr * 64 + m * 16 + fr;
                f32x4 xv[2][2];
                if (l == 0 && !down) {
#pragma unroll
                    for (int bj = 0; bj < 2; ++bj) { const int col = u.pn * 256 + bj * 128 + wc * 32 + 8 * fq; const float* xs = u.pm < 32 ? in[0] + (size_t)row * DM + col : in[1] + (size_t)(row - M_CTX) * DM + col;
                        xv[bj][0] = *(const f32x4*)xs; xv[bj][1] = *(const f32x4*)(xs + 4); }
                    asm volatile("" ::: "memory");
                } else {
#pragma unroll
                    for (int bj = 0; bj < 2; ++bj) { const u32x4 t = xw[m][bj]; xv[bj][0] = (f32x4){bf_lo(t.x), bf_hi(t.x), bf_lo(t.y), bf_hi(t.y)}; xv[bj][1] = (f32x4){bf_lo(t.z), bf_hi(t.z), bf_lo(t.w), bf_hi(t.w)}; }
                }
                float sq = 0.f;
#pragma unroll
                for (int bj = 0; bj < 2; ++bj) {
                    const int col = u.pn * 256 + bj * 128 + wc * 32 + 8 * fq;
                    bf16_t* xp = (bf16_t*)(ws + WS_XB) + (size_t)row * DM + col;
                    const f32x4 x0 = xv[bj][0] + gv[bj][0] * acc[ai][bj][m][0], x1 = xv[bj][1] + gv[bj][1] * acc[ai][bj][m][1];
                    { u32x4 t; t.x = pk_bf16(x0[0], x0[1]); t.y = pk_bf16(x0[2], x0[3]); t.z = pk_bf16(x1[0], x1[1]); t.w = pk_bf16(x1[2], x1[3]); *(u32x4*)xp = t; }
                    sq += (x0[0] * x0[0] + x0[1] * x0[1]) + (x0[2] * x0[2] + x0[3] * x0[3]) + (x1[0] * x1[0] + x1[1] * x1[1]) + (x1[2] * x1[2] + x1[3] * x1[3]);
                    if (XA) {
                        const f32x4 a0 = x0 * nsv[bj][0], a1 = x1 * nsv[bj][1];
                        u32x4 w; w.x = pk_bf16(a0[0], a0[1]); w.y = pk_bf16(a0[2], a0[3]); w.z = pk_bf16(a1[0], a1[1]); w.w = pk_bf16(a1[2], a1[3]);
                        *(u32x4*)(XA + (size_t)row * DM + col) = w;
                    }
                }
                sq += __shfl_xor(sq, 16); sq += __shfl_xor(sq, 32);
                if (fq == 0) *(LAS float*)(lds + pg8::STAGE_BYTES + (wc * 256 + ai * 128 + wr * 64 + m * 16 + fr) * 4) = sq;
            }
        }
        __syncthreads();
        { const int t = (wr * 4 + wc) * 64 + fq * 16 + fr;
          if (t < 256) { const LAS float* p = (const LAS float*)(lds + pg8::STAGE_BYTES) + t; const float sq = (p[0] + p[256]) + (p[512] + p[768]);
              atomicAdd(ssout + u.pm * 256 + t, (unsigned)(sq * SS_SCALE + 0.5f)); } }
    }
};

struct EpiGU {
    unsigned char* ws; int l;
    __device__ __forceinline__ void operator()(const AccT& acc, const pg8::Unit& u, int wr, int wc, int fr, int fq) const {
        const int roff = u.half == 2 ? 128 : 0; const bool hu = u.half != 0;
        const unsigned* ss = (const unsigned*)(ws + WS_SS) + (size_t)(2 * l + 1) * M_TOT; const float* bias = (const float*)(ws + WS_BIAS_GU) + (size_t)l * NCOND * GU_N; bf16_t* H = (bf16_t*)(ws + WS_H);
        const int cond = cond_of_tile(u.pm);
        const float* bp = bias + (size_t)cond * GU_N;
        float rs[8]; f32x4 bv[2][2];
#pragma unroll
        for (int i = 0; i < 8; ++i) rs[i] = ss_rstd(ss, u.pm * 256 + roff + (hu ? 0 : (i >> 2)) * 128 + wr * 64 + (i & 3) * 16 + fr);
#pragma unroll
        for (int bj = 0; bj < 2; ++bj) { const int col = u.pn * 256 + bj * 128 + wc * 32 + 8 * fq; bv[bj][0] = *(const f32x4*)(bp + col); bv[bj][1] = *(const f32x4*)(bp + col + 4); }
        asm volatile("" ::: "memory");
#pragma unroll
        for (int ai = 0; ai < 2; ++ai)
#pragma unroll
            for (int m = 0; m < 4; ++m) {
                if (hu && ai == 1) continue;
                const int row = u.pm * 256 + roff + ai * 128 + wr * 64 + m * 16 + fr;
                const float rstd = rs[ai * 4 + m];
                u32x4 w;
#pragma unroll
                for (int bj = 0; bj < 2; ++bj) {
                    const f32x4 b0 = bv[bj][0], b1 = bv[bj][1];
                    float hv[4];
#pragma unroll
                    for (int e = 0; e < 4; ++e) { const float gz = acc[ai][bj][m][0][e] * rstd + b0[e], uz = acc[ai][bj][m][1][e] * rstd + b1[e]; hv[e] = silu_f(gz) * uz; }
                    if (bj == 0) { w.x = pk_bf16(hv[0], hv[1]); w.y = pk_bf16(hv[2], hv[3]); } else { w.z = pk_bf16(hv[0], hv[1]); w.w = pk_bf16(hv[2], hv[3]); }
                }
                *(u32x4*)(H + (size_t)row * D_FF + u.pn * 128 + wc * 32 + 8 * fq) = w;
            }
    }
};

struct Args { const float* in[21]; float* out; unsigned char* ws; int ph_lo, ph_hi; };
struct Frame { lptr lds; int tid, lane, wave, G, bid; inptr_t in; float* out; unsigned char* ws; float* out0; unsigned char* ws0; };

template <class RowMap>
__device__ __forceinline__ void transpose_item(const float* W, int K, int N, bf16_t* WT, LAS float* scr, int item, int lane, RowMap rm) {
    const int nblk = N / 32, kb = item / nblk, nb = item % nblk, k0 = 64 * kb, n0 = 32 * nb;
    {
        const float* src = W + (size_t)(k0 + (lane >> 3)) * N + n0 + 4 * (lane & 7);
        f32x4 v[8];
#pragma unroll
        for (int i = 0; i < 8; ++i) v[i] = *(const f32x4*)(src + (size_t)(8 * i) * N);
#pragma unroll
        for (int i = 0; i < 8; ++i) { LAS float* d = scr + (8 * i + (lane >> 3)) * 33 + 4 * (lane & 7); d[0] = v[i][0]; d[1] = v[i][1]; d[2] = v[i][2]; d[3] = v[i][3]; }
    }
    asm volatile("s_waitcnt lgkmcnt(0)" ::: "memory");
    const int c = lane & 7;
#pragma unroll
    for (int jj = 0; jj < 4; ++jj) { const int n = (lane >> 3) + 8 * jj; const LAS float* s = scr + (8 * c) * 33 + n;
        u32x4 o; o.x = pk_bf16(s[0 * 33], s[1 * 33]); o.y = pk_bf16(s[2 * 33], s[3 * 33]); o.z = pk_bf16(s[4 * 33], s[5 * 33]); o.w = pk_bf16(s[6 * 33], s[7 * 33]);
        *(u32x4*)(WT + (size_t)rm(n0 + n) * K + k0 + 8 * c) = o; }
    asm volatile("s_waitcnt lgkmcnt(0)" ::: "memory");
}
struct RmId { __device__ __forceinline__ int operator()(int n) const { return n; } };
struct RmQkv { __device__ __forceinline__ int operator()(int n) const { if (n >= 1280) return n; const int hb = n & ~127, hl = n & 127, ax = hl >> 6, r = hl & 63, p = r >> 5, jj = r & 31; return hb + ax * 64 + 2 * jj + p; } };
struct RmGU { __device__ __forceinline__ int operator()(int n) const { const int isu = n >= D_FF, i = isu ? n - D_FF : n; const int m = i >> 2, pn = m >> 5, hm = m & 31;
    const int q8 = (hm & 1) * 16 + (hm >> 3) * 4 + ((hm >> 1) & 3); return 8 * (pn * 32 + q8) + 4 * isu + (i & 3); } };


template <int NKC>
__device__ __forceinline__ void adaln_layer(Frame& F, int l, int wgi, int nwg) {
    const inptr_t in = F.in;
    int* mod = (int*)(F.ws + WS_MOD);
    constexpr int KI = DM / NKC;
    if (wgi < NKC * 6) {
        LAS float* sc = (LAS float*)F.lds;
        {
            float cv[10];
#pragma unroll
            for (int q = 0; q < 10; ++q) { const int i = F.tid + q * NTHREADS, c = i >> 10, k = i & 1023; cv[q] = c == 0 ? in[6][k] : in[5][(c - 1) * DM + k]; }
#pragma unroll
            for (int q = 0; q < 10; ++q) sc[F.tid + q * NTHREADS] = cv[q] * fast_rcp(1.f + __expf(-cv[q]));
        }
        __syncthreads();
        for (int it = wgi; it < NKC * 6; it += nwg) {
            const int nc = it % 6, kc = it / 6;
            const int n = nc * 1024 + 2 * F.tid, k0 = kc * KI;
            const float* wp = in[7] + ((size_t)l * DM + k0) * 6144 + n;
            float a[NCOND][2];
#pragma unroll
            for (int c = 0; c < NCOND; ++c) { a[c][0] = 0.f; a[c][1] = 0.f; }
            for (int kb = 0; kb < KI; kb += 16) {
                f32x2 w[16];
#pragma unroll
                for (int k = 0; k < 16; ++k) w[k] = *(const f32x2*)(wp + (size_t)(kb + k) * 6144);
#pragma unroll
                for (int k = 0; k < 16; ++k)
#pragma unroll
                    for (int c = 0; c < NCOND; ++c) { const float sv = sc[c * DM + k0 + kb + k]; a[c][0] += sv * w[k].x; a[c][1] += sv * w[k].y; }
            }
            if (kc == 0) { const f32x2 b = *(const f32x2*)(in[8] + (size_t)l * 6144 + n);
#pragma unroll
                for (int c = 0; c < NCOND; ++c) { a[c][0] += b.x; a[c][1] += b.y; } }
#pragma unroll
            for (int c = 0; c < NCOND; ++c) { int* mp = mod + (size_t)(c * 4 + l) * 6144 + n; atomicAdd(mp, __float2int_rn(a[c][0] * MOD_SCALE)); atomicAdd(mp + 1, __float2int_rn(a[c][1] * MOD_SCALE)); }
        }
    }
    __syncthreads();
}

__device__ __forceinline__ void convert_set(Frame& F, int set, int gw, int NGW) {
    const inptr_t in = F.in;
    LAS float* scr = (LAS float*)(F.lds + F.wave * 16384);
    constexpr int I_IN = 16 * 160, I_SQ = 16 * 32, I_QKV = 16 * 48, I_GU = 16 * 176, I_DN = 44 * 32;
    const bool hgl = (set == 0 || set == 2);
    const int l = set == 0 ? 0 : (set == 1 ? 1 : (set == 4 ? 3 : 2)), j = l >> 1;
    const int n0 = set == 3 ? 0 : (hgl ? I_IN : I_QKV), n1 = set == 3 ? 0 : I_SQ, n2 = set == 2 ? 0 : I_GU, n3 = set == 2 ? 0 : I_DN;
    const int t0 = n0, t1 = t0 + n1, t2 = t1 + n2, t3 = t2 + n3;
    for (int it = gw; it < t3; it += NGW) {
        if (it < t0) { if (hgl) transpose_item(in[14] + (size_t)j * DM * A_IN, DM, A_IN, (bf16_t*)(F.ws + WS_W_IN) + (size_t)j * A_IN * DM, scr, it, F.lane, RmId());
                       else transpose_item(in[18] + (size_t)j * DM * QKV_N, DM, QKV_N, (bf16_t*)(F.ws + WS_W_QKV) + (size_t)j * QKV_N * DM, scr, it, F.lane, RmQkv()); }
        else if (it < t1) { const int r = it - t0; if (hgl) transpose_item(in[17] + (size_t)j * DM * DM, DM, DM, (bf16_t*)(F.ws + WS_W_OUTA) + (size_t)j * DM * DM, scr, r, F.lane, RmId());
                            else transpose_item(in[19] + (size_t)j * DM * DM, DM, DM, (bf16_t*)(F.ws + WS_W_OUTB) + (size_t)j * DM * DM, scr, r, F.lane, RmId()); }
        else if (it < t2) { const int r = it - t1; transpose_item(in[12] + (size_t)l * DM * GU_N, DM, GU_N, (bf16_t*)(F.ws + WS_W_GU) + (size_t)l * GU_N * DM, scr, r, F.lane, RmGU()); }
        else { const int r = it - t2; transpose_item(in[13] + (size_t)l * D_FF * DM, D_FF, DM, (bf16_t*)(F.ws + WS_W_DN) + (size_t)l * DM * D_FF, scr, r, F.lane, RmId()); }
    }
}
__device__ __forceinline__ void bias_layer(Frame& F, int l, int gw, int NGW) {
    const int* mod = (const int*)(F.ws + WS_MOD);
    const bool hg = (l & 1) == 0; const int j = l >> 1;
    const int part = gw & 1, gwp = gw >> 1, NW = NGW >> 1;
    const int N = part ? GU_N : (hg ? A_IN : QKV_N), shoff = part ? 3072 : 0;
    const bf16_t* wt = part ? (const bf16_t*)(F.ws + WS_W_GU) + (size_t)l * GU_N * DM : (hg ? (const bf16_t*)(F.ws + WS_W_IN) + (size_t)j * A_IN * DM : (const bf16_t*)(F.ws + WS_W_QKV) + (size_t)j * QKV_N * DM);
    float* bout = part ? (float*)(F.ws + WS_BIAS_GU) + (size_t)l * NCOND * GU_N : (hg ? (float*)(F.ws + WS_BIAS_IN) + (size_t)j * NCOND * A_IN : (float*)(F.ws + WS_BIAS_QKV) + (size_t)j * NCOND * QKV_N);
    float sh[NCOND][16];
#pragma unroll
    for (int c = 0; c < NCOND; ++c)
#pragma unroll
        for (int h = 0; h < 2; ++h) { const int* sp = mod + (size_t)(c * 4 + l) * 6144 + shoff + 512 * h + 8 * F.lane; const f32x4 a = modv4(sp), b = modv4(sp + 4);
#pragma unroll
            for (int e = 0; e < 4; ++e) { sh[c][8 * h + e] = a[e]; sh[c][8 * h + 4 + e] = b[e]; } }
    for (int r0 = 6 * gwp; r0 < N; r0 += 6 * NW) {
        u32x4 wv4[6][2];
#pragma unroll
        for (int q = 0; q < 6; ++q) { const int rq = r0 + q < N ? r0 + q : N - 1;
#pragma unroll
            for (int h = 0; h < 2; ++h) wv4[q][h] = *(const u32x4*)(wt + (size_t)rq * DM + 512 * h + 8 * F.lane); }
        float acc[6][NCOND];
#pragma unroll
        for (int q = 0; q < 6; ++q) {
#pragma unroll
            for (int c = 0; c < NCOND; ++c) acc[q][c] = 0.f;
#pragma unroll
            for (int h = 0; h < 2; ++h) { const u32x4 w = wv4[q][h];
                const float wv[8] = {bf_lo(w.x), bf_hi(w.x), bf_lo(w.y), bf_hi(w.y), bf_lo(w.z), bf_hi(w.z), bf_lo(w.w), bf_hi(w.w)};
#pragma unroll
                for (int c = 0; c < NCOND; ++c)
#pragma unroll
                    for (int e = 0; e < 8; ++e) acc[q][c] += sh[c][8 * h + e] * wv[e]; }
        }
#pragma unroll
        for (int o = 1; o < 64; o <<= 1)
#pragma unroll
            for (int q = 0; q < 6; ++q)
#pragma unroll
                for (int c = 0; c < NCOND; ++c) acc[q][c] += __shfl_xor(acc[q][c], o);
        if (F.lane == 0) {
#pragma unroll
            for (int q = 0; q < 6; ++q)
                if (r0 + q < N) {
#pragma unroll
                    for (int c = 0; c < NCOND; ++c) bout[(size_t)c * N + r0 + q] = acc[q][c]; }
        }
    }
}

__device__ __forceinline__ void phase0a(Frame& F) {
    const int gw = F.bid * NWAVES + F.wave, NGW = F.G * NWAVES;
    const inptr_t in = F.in;
    adaln_layer<32>(F, 0, F.bid, F.G);
    convert_set(F, 0, gw, NGW);
    const int gt = F.bid * NTHREADS + F.tid, NGT = F.G * NTHREADS;
    for (int i = gt; i < 2 * 1024; i += NGT) { const float a = in[15][i], b = in[15][2048 + i]; const float mx = fmaxf(a, b), ea = __expf(a - mx), eb = __expf(b - mx);
        float* lb = (float*)(F.ws + WS_LB); lb[i] = 0.f; lb[2048 + i] = eb / (ea + eb); }
    for (int i = gt; i < 2 * 64 * 32; i += NGT) { const int jx = i & 31, pos = (i >> 5) & 63; const float inv = exp2f(-(float)jx * (13.287712379549449f / 32.f)); const float ang = (float)pos * inv;
        float* rp = (float*)(F.ws + WS_ROPE); rp[i] = cosf(ang); rp[2 * 64 * 32 + i] = sinf(ang); }
    for (int i = gt; i < 4 * 2 * 512 * 2 * 16; i += NGT) {
        const int rowid = i >> 4, o0 = (i & 15) * 8; float v[8];
#pragma unroll
        for (int e = 0; e < 8; ++e) { const int hl = o0 + e, ax = hl >> 6, r = hl & 63, jj = r >> 1, p = r & 1; v[e] = in[2][(size_t)rowid * 128 + ax * 64 + 32 * p + jj]; }
        u32x4 w; w.x = pk_bf16(v[0], v[1]); w.y = pk_bf16(v[2], v[3]); w.z = pk_bf16(v[4], v[5]); w.w = pk_bf16(v[6], v[7]);
        *(u32x4*)((bf16_t*)(F.ws + WS_CK) + (size_t)rowid * 128 + o0) = w;
    }
    for (int i = gt; i < 4 * 2 * 2 * 64 * 128; i += NGT) {
        const int d = i & 127, p8 = (i >> 7) & 63, kvh = (i >> 13) & 1, bj = i >> 14; float v[8];
#pragma unroll
        for (int e = 0; e < 8; ++e) v[e] = in[3][((size_t)(bj * 512 + p8 * 8 + e) * 2 + kvh) * 128 + d];
        u32x4 w; w.x = pk_bf16(v[0], v[1]); w.y = pk_bf16(v[2], v[3]); w.z = pk_bf16(v[4], v[5]); w.w = pk_bf16(v[6], v[7]);
        *(u32x4*)((bf16_t*)(F.ws + WS_CVT) + ((size_t)(bj * 2 + kvh) * 128 + d) * 512 + p8 * 8) = w;
    }
}

__device__ __forceinline__ void phase0b(Frame& F) {
    const int gw = F.bid * NWAVES + F.wave, NGW = F.G * NWAVES;
    const int* mod = (const int*)(F.ws + WS_MOD);
    {
        const float* nw = F.in[9];
        f32x4 xvA[2][4], wvA[4], xvB[2][4], wvB[4];
#define XA_LOAD(xv, wv, r0_) { const int r0c = (r0_) < M_TOT ? (r0_) : M_TOT - 2; const int* sc = mod + (size_t)(cond_of_row(r0c) * 4 + 0) * 6144 + 1024; \
        _Pragma("unroll") for (int jx = 0; jx < 4; ++jx) { const int k = 4 * F.lane + 256 * jx; wv[jx] = *(const f32x4*)(nw + k) * (modv4(sc + k) + 1.f); } \
        _Pragma("unroll") for (int q = 0; q < 2; ++q) { const int row = r0c + q; const float* xr = row < M_CTX ? F.in[0] + (size_t)row * DM : F.in[1] + (size_t)(row - M_CTX) * DM; \
            _Pragma("unroll") for (int jx = 0; jx < 4; ++jx) xv[q][jx] = *(const f32x4*)(xr + 4 * F.lane + 256 * jx); } \
        asm volatile("" ::: "memory"); }
#define XA_PROC(xv, wv, r0_) { _Pragma("unroll") for (int q = 0; q < 2; ++q) { const int row = (r0_) + q; bf16_t* dst = (bf16_t*)(F.ws + WS_XA) + (size_t)row * DM; float sq = 0.f; \
            _Pragma("unroll") for (int jx = 0; jx < 4; ++jx) { const int k = 4 * F.lane + 256 * jx; const f32x4 v = xv[q][jx]; \
                sq += (v.x * v.x + v.y * v.y) + (v.z * v.z + v.w * v.w); \
                const f32x4 a = v * wv[jx]; u32x2 w; w.x = pk_bf16(a[0], a[1]); w.y = pk_bf16(a[2], a[3]); *(u32x2*)(dst + k) = w; } \
            sq = wave_sum(sq); \
            if (F.lane == 0) ((unsigned*)(F.ws + WS_SS))[row] = (unsigned)(sq * SS_SCALE + 0.5f); } }
        int row0 = 2 * gw;
        XA_LOAD(xvA, wvA, row0)
        while (row0 < M_TOT) {
            XA_LOAD(xvB, wvB, row0 + 2 * NGW)
            XA_PROC(xvA, wvA, row0)
            row0 += 2 * NGW;
            if (row0 >= M_TOT) break;
            XA_LOAD(xvA, wvA, row0 + 2 * NGW)
            XA_PROC(xvB, wvB, row0)
            row0 += 2 * NGW;
        }
#undef XA_LOAD
#undef XA_PROC
    }
    bias_layer(F, 0, gw, NGW);
}

constexpr int SB_QP = 0, SB_KP = SB_QP + 32 * 272, SB_KPT = SB_KP + 32 * 272, SB_VT = SB_KPT + 128 * 80, SB_D15 = SB_VT + 128 * 80, SB_DX = SB_D15 + 512, SB_SIZE = SB_DX + 512;
constexpr int SC_OT = 2 * SB_SIZE, SC_OTSZ = 32 * 272, SC_OFW = SC_OT + 2 * SC_OTSZ, SC_END = SC_OFW + 256 * 256;
static_assert(SC_END <= 163840 - 256, "scan lds");
struct ScanP { const bf16_t* Q; const bf16_t* V; bf16_t* KF; bf16_t* KB; const unsigned short* GF; const unsigned short* GB; const float* s_in; float* s_out; float* useg; float* dseg; int j; bf16_t* OFW; bf16_t* A2; const float* gn; };
struct ScanRegs { unsigned q[4], g[4], v[4]; };

template <bool LIGHT>
__device__ __forceinline__ void scan_load(ScanRegs& R, const bf16_t* Q, const bf16_t* Kp, const unsigned short* Gp, const bf16_t* V, int rowbase, int T, int dir, int ilc, int tg, int coloff) {
#pragma unroll
    for (int ii = 0; ii < 4; ++ii) { const int il = ilc + 4 * tg + ii; const int tok = dir ? (T - 1 - il) : il; const int ro = (rowbase + tok) * DM + coloff;
        if (!LIGHT) R.q[ii] = *(const unsigned*)(Q + ro); R.g[ii] = *(const unsigned*)(Gp + ro); R.v[ii] = *(const unsigned*)(V + ro); }
}
template <bool LIGHT>
__device__ __forceinline__ void scan_compute(lptr Lb, const ScanRegs& R, int lane, int w, float (&dacc)[2], float (&dxp)[2]) {
    const int tg = lane >> 3, dp = lane & 7;
    float cl[4][2], kq0[4][2]; float t0 = 0.f, t1 = 0.f;
#pragma unroll
    for (int ii = 0; ii < 4; ++ii) { const f32x2 gg = unpk_f16(R.g[ii]); t0 += gg.x; t1 += gg.y; cl[ii][0] = t0; cl[ii][1] = t1; kq0[ii][0] = 1.f - fast_exp2(gg.x); kq0[ii][1] = 1.f - fast_exp2(gg.y); }
    float s0 = t0, s1 = t1;
    { float u0 = __shfl_up(s0, 8), u1 = __shfl_up(s1, 8); if (tg >= 1) { s0 += u0; s1 += u1; } }
    { float u0 = __shfl_up(s0, 16), u1 = __shfl_up(s1, 16); if (tg >= 2) { s0 += u0; s1 += u1; } }
    { float u0 = __shfl_up(s0, 32), u1 = __shfl_up(s1, 32); if (tg >= 4) { s0 += u0; s1 += u1; } }
    const float b15[2] = {__shfl(s0, 24 + dp), __shfl(s1, 24 + dp)}, b31[2] = {__shfl(s0, 56 + dp), __shfl(s1, 56 + dp)};
    const float pre[2] = {s0 - t0 - b15[0], s1 - t1 - b15[1]};
    const int pos = 32 * (w >> 1) + 8 * (dp >> 1) + 4 * (w & 1) + 2 * (dp & 1);
    const int p0 = 8 * (tg & 3) + 4 * (tg >> 2);
    float kt[2][4];
#pragma unroll
    for (int ii = 0; ii < 4; ++ii) {
        const int i = 4 * tg + ii;
        float kq[2], qq[2];
#pragma unroll
        for (int x = 0; x < 2; ++x) {
            const float dl = pre[x] + cl[ii][x];
            const float kv = kq0[ii][x];
            kq[x] = kv * fast_exp2(fminf(-dl, 100.f)); kt[x][ii] = kq[x];
            if constexpr (!LIGHT) { const float qv = x ? bf_hi(R.q[ii]) : bf_lo(R.q[ii]); qq[x] = qv * fast_exp2(fminf(dl, 100.f)); }
        }
        if constexpr (!LIGHT) {
            const int so = i * 256 + 16 * ((pos >> 3) ^ (i & 15)) + ((2 * pos) & 15);
            *(LAS unsigned*)(Lb + SB_QP + so) = pk_bf16(qq[0], qq[1]);
            *(LAS unsigned*)(Lb + SB_KP + so) = pk_bf16(kq[0], kq[1]);
        }
    }
    const int d0 = 16 * w + 2 * dp;
    const int p0s = 2 * p0 ^ ((((dp >> 1) ^ (dp >> 2)) & 1) << 4);
#pragma unroll
    for (int x = 0; x < 2; ++x) { u32x2 v; v.x = pk_bf16(kt[x][0], kt[x][1]); v.y = pk_bf16(kt[x][2], kt[x][3]); *(LAS u32x2*)(Lb + SB_KPT + (d0 + x) * 80 + p0s) = v; }
    { u32x2 v0, v1; v0.x = (R.v[0] & 0xffffu) | (R.v[1] << 16); v0.y = (R.v[2] & 0xffffu) | (R.v[3] << 16); v1.x = (R.v[0] >> 16) | (R.v[1] & 0xffff0000u); v1.y = (R.v[2] >> 16) | (R.v[3] & 0xffff0000u);
      *(LAS u32x2*)(Lb + SB_VT + d0 * 80 + p0s) = v0; *(LAS u32x2*)(Lb + SB_VT + (d0 + 1) * 80 + p0s) = v1; }
    if (tg == 0) { *(LAS f32x2*)(Lb + SB_D15 + 4 * d0) = (f32x2){fast_exp2(b15[0] + dxp[0]), fast_exp2(b15[1] + dxp[1])}; *(LAS f32x2*)(Lb + SB_DX + 4 * d0) = (f32x2){fast_exp2(b31[0] - b15[0]), fast_exp2(b31[1] - b15[1])}; }
    dxp[0] = b31[0] - b15[0]; dxp[1] = b31[1] - b15[1];
    dacc[0] += b31[0]; dacc[1] += b31[1];
}
template <bool LIGHT>
__device__ __forceinline__ void scan_mfma(lptr Lb, lptr Lot, int ost, f32x4 (&S)[8], int lane, int w) {
    const int g = lane >> 4, c = lane & 15;
#pragma unroll
    for (int a = 0; a < 8; ++a) S[a] = S[a] * *(const LAS f32x4*)(Lb + SB_D15 + (16 * a + 4 * g) * 4);
    const int gs = 16 * (g ^ (((c >> 2) ^ (c >> 3)) & 1));
    const int qs = c * 256 + 16 * (g ^ (c & 3)) + 64 * (c >> 2);
    const bf16x8 vb = *(const LAS bf16x8*)(Lb + SB_VT + (16 * w + c) * 80 + gs);
    f32x4 ao0 = {0.f, 0.f, 0.f, 0.f}, ao1 = {0.f, 0.f, 0.f, 0.f};
    if constexpr (!LIGHT) {
        bf16x8 qa[2][4];
#pragma unroll
        for (int it = 0; it < 2; ++it)
#pragma unroll
            for (int ks = 0; ks < 4; ++ks) qa[it][ks] = *(const LAS bf16x8*)(Lb + SB_QP + it * 4096 + (qs ^ (64 * ks)));
        f32x4 ao[2] = {(f32x4){0.f, 0.f, 0.f, 0.f}, (f32x4){0.f, 0.f, 0.f, 0.f}};
#pragma unroll
        for (int ks = 0; ks < 4; ++ks) {
            u32x4 sw; sw.x = pk_bf16(S[2 * ks][0], S[2 * ks][1]); sw.y = pk_bf16(S[2 * ks][2], S[2 * ks][3]); sw.z = pk_bf16(S[2 * ks + 1][0], S[2 * ks + 1][1]); sw.w = pk_bf16(S[2 * ks + 1][2], S[2 * ks + 1][3]);
            const bf16x8 sb = __builtin_bit_cast(bf16x8, sw);
            ao[0] = __builtin_amdgcn_mfma_f32_16x16x32_bf16(qa[0][ks], sb, ao[0], 0, 0, 0);
            ao[1] = __builtin_amdgcn_mfma_f32_16x16x32_bf16(qa[1][ks], sb, ao[1], 0, 0, 0);
        }
        f32x4 t00 = {0.f, 0.f, 0.f, 0.f}, t01 = {0.f, 0.f, 0.f, 0.f}, t11 = {0.f, 0.f, 0.f, 0.f};
#pragma unroll
        for (int ks = 0; ks < 4; ++ks) {
            const bf16x8 k0 = *(const LAS bf16x8*)(Lb + SB_KP + (qs ^ (64 * ks))), k1 = *(const LAS bf16x8*)(Lb + SB_KP + 4096 + (qs ^ (64 * ks)));
            t00 = __builtin_amdgcn_mfma_f32_16x16x32_bf16(k0, qa[0][ks], t00, 0, 0, 0);
            t01 = __builtin_amdgcn_mfma_f32_16x16x32_bf16(k0, qa[1][ks], t01, 0, 0, 0);
            t11 = __builtin_amdgcn_mfma_f32_16x16x32_bf16(k1, qa[1][ks], t11, 0, 0, 0);
        }
#pragma unroll
        for (int r = 0; r < 4; ++r) { if (4 * g + r > c) { t00[r] = 0.f; t11[r] = 0.f; } }
        { u32x4 pw; pw.x = pk_bf16(t00[0], t00[1]); pw.y = pk_bf16(t00[2], t00[3]); pw.z = 0u; pw.w = 0u;
          ao[0] = __builtin_amdgcn_mfma_f32_16x16x32_bf16(__builtin_bit_cast(bf16x8, pw), vb, ao[0], 0, 0, 0); }
        { u32x4 pw; pw.x = pk_bf16(t01[0], t01[1]); pw.y = pk_bf16(t01[2], t01[3]); pw.z = pk_bf16(t11[0], t11[1]); pw.w = pk_bf16(t11[2], t11[3]);
          ao[1] = __builtin_amdgcn_mfma_f32_16x16x32_bf16(__builtin_bit_cast(bf16x8, pw), vb, ao[1], 0, 0, 0); }
        ao0 = ao[0]; ao1 = ao[1];
    }
#pragma unroll
    for (int a = 0; a < 8; ++a) {
        const bf16x8 ka = *(const LAS bf16x8*)(Lb + SB_KPT + (16 * a + c) * 80 + gs);
        S[a] = __builtin_amdgcn_mfma_f32_16x16x32_bf16(ka, vb, S[a], 0, 0, 0);
    }
    if constexpr (!LIGHT) {
#pragma unroll
        for (int r = 0; r < 4; ++r) { *(LAS bf16_t*)(Lot + (4 * g + r) * ost + (16 * w + c) * 2) = to_bf16(ao0[r]); *(LAS bf16_t*)(Lot + (16 + 4 * g + r) * ost + (16 * w + c) * 2) = to_bf16(ao1[r]); }
    }
}
struct FlushRegs { u32x4 sg; };
__device__ __forceinline__ void scan_flush_pre(FlushRegs& R, const ScanP& P, int rowbase, int T, int ilc, int h, int tid) {
    const int i = tid >> 4, ch = tid & 15; const int il = ilc + i; const int tok = T - 1 - il; const int off = (rowbase + tok) * DM + h * 128 + 8 * ch;
    R.sg = *(const u32x4*)(P.A2 + off);
}
__device__ __forceinline__ void scan_flush(lptr Lot, lptr Lofw, const FlushRegs& R, const ScanP& P, int rowbase, int T, int ilc, int lo, int h, int tid) {
    const int i = tid >> 4, ch = tid & 15; const int il = ilc + i; const int tok = T - 1 - il;
    const int off = (rowbase + tok) * DM + h * 128 + 8 * ch;
    const u32x4 ob = *(const LAS u32x4*)(Lot + i * 272 + 16 * ch);
    const u32x4 of = *(const LAS u32x4*)(Lofw + (255 - (lo + i)) * 256 + 16 * ch);
    const u32x4 sg = R.sg;
    const f32x4 g0 = *(const f32x4*)(P.gn + h * 128 + 8 * ch), g1 = *(const f32x4*)(P.gn + h * 128 + 8 * ch + 4);
    float v[8];
#pragma unroll
    for (int e = 0; e < 4; ++e) { v[2 * e] = bf_lo(of[e]) + bf_lo(ob[e]); v[2 * e + 1] = bf_hi(of[e]) + bf_hi(ob[e]); }
    float sq = 0.f;
#pragma unroll
    for (int e = 0; e < 8; ++e) sq += v[e] * v[e];
    sq += __shfl_xor(sq, 1); sq += __shfl_xor(sq, 2); sq += __shfl_xor(sq, 4); sq += __shfl_xor(sq, 8);
    const float rs = rsqrtf(sq * (1.f / 128.f) + EPS);
    u32x4 w;
    w.x = pk_bf16(v[0] * rs * g0[0] * bf_lo(sg.x), v[1] * rs * g0[1] * bf_hi(sg.x)); w.y = pk_bf16(v[2] * rs * g0[2] * bf_lo(sg.y), v[3] * rs * g0[3] * bf_hi(sg.y));
    w.z = pk_bf16(v[4] * rs * g1[0] * bf_lo(sg.z), v[5] * rs * g1[1] * bf_hi(sg.z)); w.w = pk_bf16(v[6] * rs * g1[2] * bf_lo(sg.w), v[7] * rs * g1[3] * bf_hi(sg.w));
    *(u32x4*)(P.A2 + off) = w;
}

struct ScanNext { int rowbase, T, il0, h, dir; };
template <bool LIGHT>
__device__ __forceinline__ void scan_item(Frame& F, const ScanP& P, ScanRegs& RA, ScanRegs& RB, const ScanNext NX, int rowbase, int T, int il0, int nch, int h, int dir,
                                          const float* s0, int nfold, const float* fu, const float* fd, float* sfin, float* dout) {
    const lptr L = F.lds; const int lane = F.lane, w = F.wave, g = lane >> 4, c = lane & 15;
    bf16_t* Kp = dir ? P.KB : P.KF; const unsigned short* Gp = dir ? P.GB : P.GF;
    f32x4 S[8];
    {
        int l3 = lane; asm volatile("" : "+v"(l3));
        const int lo = ((l3 >> 4) * 4) * 128 + 16 * w + (l3 & 15);
        if (s0) { const float* sp0 = s0 + lo;
#pragma unroll
            for (int a = 0; a < 8; ++a)
#pragma unroll
                for (int r = 0; r < 4; ++r) S[a][r] = sp0[(16 * a + r) * 128];
        } else {
#pragma unroll
            for (int a = 0; a < 8; ++a) S[a] = (f32x4){0.f, 0.f, 0.f, 0.f};
        }
        if constexpr (!LIGHT) {
            const int k2 = nfold >> 1, nf = k2 + (nfold & 1);
#define FOLD_LD(U, D, slot_) { const float* up = fu + (size_t)(slot_) * 16384 + lo; const float* dp = fd + (slot_) * 128 + (l3 >> 4) * 4; \
    _Pragma("unroll") for (int a = 0; a < 8; ++a) { D[a] = *(const f32x4*)(dp + 16 * a); _Pragma("unroll") for (int r = 0; r < 4; ++r) U[4 * a + r] = up[(16 * a + r) * 128]; } }
#define FOLD_DO(U, D) { _Pragma("unroll") for (int a = 0; a < 8; ++a) { _Pragma("unroll") for (int r = 0; r < 4; ++r) S[a][r] = fast_exp2(D[a][r]) * S[a][r] + U[4 * a + r]; } }
            for (int f = 0; f < nf; f += 2) {
                float U0[32], U1[32]; f32x4 D0[8], D1[8];
                const bool two = f + 1 < nf;
                const int s0_ = f < k2 ? 2 * f + 1 : nfold - 1, s1_ = (f + 1) < k2 ? 2 * f + 3 : nfold - 1;
                FOLD_LD(U0, D0, s0_)
                if (two) FOLD_LD(U1, D1, s1_)
                FOLD_DO(U0, D0)
                if (two) FOLD_DO(U1, D1)
            }
#undef FOLD_LD
#undef FOLD_DO
        }
    }
    float dacc[2] = {0.f, 0.f}, dxp[2] = {0.f, 0.f};
    const int tg = lane >> 3, coloff = h * 128 + 16 * w + 2 * (lane & 7);
    FlushRegs FR; FR.sg = (u32x4){0u, 0u, 0u, 0u};
    const unsigned short* nGp = NX.dir ? P.GB : P.GF; const int ncoloff = NX.h * 128 + 16 * w + 2 * (lane & 7);
    scan_compute<LIGHT>(L, RA, lane, w, dacc, dxp);
    scan_load<LIGHT>(RA, P.Q, Kp, Gp, P.V, rowbase, T, dir, il0 + 32 * (nch > 2 ? 2 : nch - 1), tg, coloff);
    __syncthreads();
    for (int c2 = 0; c2 < nch; c2 += 2) {
        if (!LIGHT) scan_flush_pre(FR, P, rowbase, T, il0 + 32 * (c2 > 0 ? c2 - 1 : 0), h, F.tid);
        scan_mfma<LIGHT>(L, dir ? L + SC_OT : L + SC_OFW + (32 * c2) * 256, dir ? 272 : 256, S, lane, w);
        scan_compute<LIGHT>(L + SB_SIZE, RB, lane, w, dacc, dxp);
        { const bool nx = c2 + 3 > nch;
          scan_load<LIGHT>(RB, P.Q, Kp, nx ? nGp : Gp, P.V, nx ? NX.rowbase : rowbase, nx ? NX.T : T, nx ? NX.dir : dir, nx ? NX.il0 + 32 : il0 + 32 * (c2 + 3 < nch ? c2 + 3 : nch - 1), tg, nx ? ncoloff : coloff); }
        if (!LIGHT && dir && c2 > 0) scan_flush(L + SC_OT + SC_OTSZ, L + SC_OFW, FR, P, rowbase, T, il0 + 32 * (c2 - 1), 32 * (c2 - 1), h, F.tid);
        __syncthreads();
        if (!LIGHT) scan_flush_pre(FR, P, rowbase, T, il0 + 32 * c2, h, F.tid);
        scan_mfma<LIGHT>(L + SB_SIZE, dir ? L + SC_OT + SC_OTSZ : L + SC_OFW + (32 * (c2 + 1)) * 256, dir ? 272 : 256, S, lane, w);
        if (c2 + 2 < nch) scan_compute<LIGHT>(L, RA, lane, w, dacc, dxp);
        { const bool nx = c2 + 4 > nch;
          scan_load<LIGHT>(RA, P.Q, Kp, nx ? nGp : Gp, P.V, nx ? NX.rowbase : rowbase, nx ? NX.T : T, nx ? NX.dir : dir, nx ? NX.il0 : il0 + 32 * (c2 + 4 < nch ? c2 + 4 : nch - 1), tg, nx ? ncoloff : coloff); }
        if (!LIGHT && dir) scan_flush(L + SC_OT, L + SC_OFW, FR, P, rowbase, T, il0 + 32 * c2, 32 * c2, h, F.tid);
        __syncthreads();
    }
    if (!LIGHT && dir) { scan_flush_pre(FR, P, rowbase, T, il0 + 32 * (nch - 1), h, F.tid); scan_flush(L + SC_OT + SC_OTSZ, L + SC_OFW, FR, P, rowbase, T, il0 + 32 * (nch - 1), 32 * (nch - 1), h, F.tid); }
    if (sfin) {
        {
            const int g2 = lane >> 4;
#pragma unroll
            for (int a = 0; a < 8; ++a) S[a] = S[a] * *(const LAS f32x4*)(L + SB_SIZE + SB_DX + (16 * a + 4 * g2) * 4);
        }
        int l2 = lane; asm volatile("" : "+v"(l2));
        float* sp = sfin + ((l2 >> 4) * 4) * 128 + 16 * w + (l2 & 15);
#pragma unroll
        for (int a = 0; a < 8; ++a)
#pragma unroll
            for (int r = 0; r < 4; ++r) sp[(16 * a + r) * 128] = S[a][r];
    }
    if (LIGHT && dout && (lane >> 3) == 0) *(f32x2*)(dout + 16 * w + 2 * (lane & 7)) = (f32x2){dacc[0], dacc[1]};
    __syncthreads();
}
constexpr int LB_KPT = 0, LB_VT = 18432, LB_D = 36864, LB_SIZE = 37376;
struct LightRegs { unsigned g[8], v[8]; };
__device__ __forceinline__ void light_load(LightRegs& R, const unsigned short* Gp, const bf16_t* V, int rowbase, int T, int dir, int ilc, int tg, int coloff) {
#pragma unroll
    for (int j = 0; j < 8; ++j) { const int il = ilc + 32 * (j >> 2) + 4 * tg + (j & 3); const int tok = dir ? (T - 1 - il) : il; const int ro = (rowbase + tok) * DM + coloff;
        R.g[j] = *(const unsigned*)(Gp + ro); R.v[j] = *(const unsigned*)(V + ro); }
}
__device__ __forceinline__ void light_compute(lptr Lb, const LightRegs& R, int lane, int w, float (&dacc)[2]) {
    const int tg = lane >> 3, dp = lane & 7;
    float cl[8][2], k0[8][2], t[2][2] = {{0.f, 0.f}, {0.f, 0.f}};
#pragma unroll
    for (int j = 0; j < 8; ++j) { const f32x2 gg = unpk_f16(R.g[j]); const int hh = j >> 2; t[hh][0] += gg.x; t[hh][1] += gg.y; cl[j][0] = t[hh][0]; cl[j][1] = t[hh][1];
        k0[j][0] = 1.f - fast_exp2(gg.x); k0[j][1] = 1.f - fast_exp2(gg.y); }
    float sc[2][2];
#pragma unroll
    for (int hh = 0; hh < 2; ++hh)
#pragma unroll
        for (int x = 0; x < 2; ++x) { float v = t[hh][x];
            { const float u = __shfl_up(v, 8); if (tg >= 1) v += u; } { const float u = __shfl_up(v, 16); if (tg >= 2) v += u; } { const float u = __shfl_up(v, 32); if (tg >= 4) v += u; }
            sc[hh][x] = v; }
    float H0[2], bend[2];
#pragma unroll
    for (int x = 0; x < 2; ++x) { H0[x] = __shfl(sc[0][x], 56 + dp); bend[x] = H0[x] + __shfl(sc[1][x], 56 + dp); }
    const int f = ((dp >> 1) ^ (dp >> 2)) & 1, d0 = 16 * w + 2 * dp;
#pragma unroll
    for (int hh = 0; hh < 2; ++hh) {
        const int co = 16 * ((4 * hh + (tg >> 1)) ^ f) + 8 * (tg & 1);
#pragma unroll
        for (int x = 0; x < 2; ++x) {
            const float pre = (hh ? H0[x] : 0.f) + (sc[hh][x] - t[hh][x]) - bend[x];
            float kk[4];
#pragma unroll
            for (int ii = 0; ii < 4; ++ii) kk[ii] = k0[4 * hh + ii][x] * fast_exp2(-(pre + cl[4 * hh + ii][x]));
            u32x2 v; v.x = pk_bf16(kk[0], kk[1]); v.y = pk_bf16(kk[2], kk[3]);
            *(LAS u32x2*)(Lb + LB_KPT + (d0 + x) * 144 + co) = v;
        }
        const unsigned* rv = R.v + 4 * hh;
        u32x2 v0, v1; v0.x = (rv[0] & 0xffffu) | (rv[1] << 16); v0.y = (rv[2] & 0xffffu) | (rv[3] << 16); v1.x = (rv[0] >> 16) | (rv[1] & 0xffff0000u); v1.y = (rv[2] >> 16) | (rv[3] & 0xffff0000u);
        *(LAS u32x2*)(Lb + LB_VT + d0 * 144 + co) = v0; *(LAS u32x2*)(Lb + LB_VT + (d0 + 1) * 144 + co) = v1;
    }
    if (tg == 0) *(LAS f32x2*)(Lb + LB_D + 4 * d0) = (f32x2){fast_exp2(bend[0]), fast_exp2(bend[1])};
    dacc[0] += bend[0]; dacc[1] += bend[1];
}
__device__ __forceinline__ void light_mfma(lptr Lb, f32x4 (&S)[8], int lane, int w) {
    const int g = lane >> 4, c = lane & 15;
    const int gs = 16 * (g ^ (((c >> 2) ^ (c >> 3)) & 1));
#pragma unroll
    for (int a = 0; a < 8; ++a) S[a] = S[a] * *(const LAS f32x4*)(Lb + LB_D + (16 * a + 4 * g) * 4);
    const bf16x8 vb0 = *(const LAS bf16x8*)(Lb + LB_VT + (16 * w + c) * 144 + gs), vb1 = *(const LAS bf16x8*)(Lb + LB_VT + (16 * w + c) * 144 + 64 + gs);
#pragma unroll
    for (int a = 0; a < 8; ++a) {
        const bf16x8 ka0 = *(const LAS bf16x8*)(Lb + LB_KPT + (16 * a + c) * 144 + gs), ka1 = *(const LAS bf16x8*)(Lb + LB_KPT + (16 * a + c) * 144 + 64 + gs);
        S[a] = __builtin_amdgcn_mfma_f32_16x16x32_bf16(ka0, vb0, S[a], 0, 0, 0);
        S[a] = __builtin_amdgcn_mfma_f32_16x16x32_bf16(ka1, vb1, S[a], 0, 0, 0);
    }
}
__device__ __forceinline__ void light_item(Frame& F, const ScanP& P, LightRegs& RA, LightRegs& RB, f32x4 (&S)[8], float (&dacc)[2], const ScanNext NX, int rowbase, int T, int il0, int h, int dir, float* sfin, float* dout) {
    const lptr L = F.lds; const int lane = F.lane, w = F.wave;
    const unsigned short* Gp = dir ? P.GB : P.GF; const unsigned short* nGp = NX.dir ? P.GB : P.GF;
    const int tg = lane >> 3, coloff = h * 128 + 16 * w + 2 * (lane & 7), ncoloff = NX.h * 128 + 16 * w + 2 * (lane & 7);
    light_compute(L, RA, lane, w, dacc);
    light_load(RA, Gp, P.V, rowbase, T, dir, il0 + 128, tg, coloff);
    __syncthreads();
#pragma unroll
    for (int st = 0; st < 4; st += 2) {
        light_mfma(L, S, lane, w);
        light_compute(L + LB_SIZE, RB, lane, w, dacc);
        { const bool nx = st + 3 > 4;
          light_load(RB, nx ? nGp : Gp, P.V, nx ? NX.rowbase : rowbase, nx ? NX.T : T, nx ? NX.dir : dir, nx ? NX.il0 + 64 : il0 + 64 * (st + 3), tg, nx ? ncoloff : coloff); }
        __syncthreads();
        light_mfma(L + LB_SIZE, S, lane, w);
        if (st + 2 < 4) light_compute(L, RA, lane, w, dacc);
        { const bool nx = st + 4 > 4;
          light_load(RA, nx ? nGp : Gp, P.V, nx ? NX.rowbase : rowbase, nx ? NX.T : T, nx ? NX.dir : dir, nx ? NX.il0 : il0 + 64 * 3, tg, nx ? ncoloff : coloff); }
        __syncthreads();
    }
    {
        int l2 = lane; asm volatile("" : "+v"(l2));
        float* sp = sfin + ((l2 >> 4) * 4) * 128 + 16 * w + (l2 & 15);
#pragma unroll
        for (int a = 0; a < 8; ++a)
#pragma unroll
            for (int r = 0; r < 4; ++r) sp[(16 * a + r) * 128] = S[a][r];
    }
    if ((lane >> 3) == 0) *(f32x2*)(dout + 16 * w + 2 * (lane & 7)) = (f32x2){dacc[0], dacc[1]};
    __syncthreads();
}
__device__ __forceinline__ void scan_phase_a(Frame& F, const ScanP& P) {
    if (F.bid >= 256) return;
    const int tg = F.lane >> 3;
    const bool pair = F.bid < 192;
    const int seq = pair ? F.bid / 3 : F.bid - 192, sg0 = pair ? 2 * (F.bid - 3 * seq) : 6;
    const int b = seq >> 4, h = (seq >> 1) & 7, dir = seq & 1, rowbase = M_CTX + b * 2048, coloff = h * 128 + 16 * F.wave + 2 * (F.lane & 7);
    LightRegs RA, RB;
    light_load(RA, dir ? P.GB : P.GF, P.V, rowbase, 2048, dir, 256 * sg0, tg, coloff);
    light_load(RB, dir ? P.GB : P.GF, P.V, rowbase, 2048, dir, 256 * sg0 + 64, tg, coloff);
    f32x4 S[8];
#pragma unroll
    for (int a = 0; a < 8; ++a) S[a] = (f32x4){0.f, 0.f, 0.f, 0.f};
    float dacc[2] = {0.f, 0.f};
    const int nit = pair ? 2 : 1;
    for (int q = 0; q < nit; ++q) {
        const int sg = sg0 + q, sgn = (q + 1 < nit) ? sg + 1 : sg;
        const ScanNext NX{rowbase, 2048, 256 * sgn, h, dir};
        light_item(F, P, RA, RB, S, dacc, NX, rowbase, 2048, 256 * sg, h, dir, P.useg + (size_t)(seq * 7 + sg) * 16384, P.dseg + (seq * 7 + sg) * 128);
    }
}
struct ScanCItem { int rowbase, T, il0, h; };
__device__ __forceinline__ ScanCItem scan_c_item(int it, int dir) {
    ScanCItem r;
    if (it < 256) { const int b = it >> 6, sg = it & 7; r.h = (it >> 3) & 7; r.rowbase = M_CTX + b * 2048; r.T = 2048; r.il0 = 256 * (dir ? 7 - sg : sg); }
    else { const int q = it - 256; r.h = q & 7; r.rowbase = (q >> 3) * 256; r.T = 256; r.il0 = 0; }
    return r;
}
__device__ __forceinline__ void scan_phase_c(Frame& F, const ScanP& P) {
    if (F.bid >= 512) return;
    const int tg = F.lane >> 3;
    ScanRegs RA, RB;
    {   const ScanCItem c = scan_c_item(F.bid, 0); const int coloff = c.h * 128 + 16 * F.wave + 2 * (F.lane & 7);
        scan_load<false>(RA, P.Q, nullptr, P.GF, P.V, c.rowbase, c.T, 0, c.il0, tg, coloff);
        scan_load<false>(RB, P.Q, nullptr, P.GF, P.V, c.rowbase, c.T, 0, c.il0 + 32, tg, coloff);
    }
    for (int it = F.bid; it < 512; it += F.G) {
        for (int dir = 0; dir < 2; ++dir) {
            int rowbase, T, il0, h, nfold; const float* s0; const float* fu; const float* fd; float* sfin;
            if (it < 256) {
                const int b = it >> 6, h_ = (it >> 3) & 7, sg = it & 7; h = h_;
                const int seq = (b * 8 + h) * 2 + dir, sgd = dir ? 7 - sg : sg;
                rowbase = M_CTX + b * 2048; T = 2048; il0 = 256 * sgd; nfold = sgd; s0 = P.s_in + ((size_t)((b * 2 + P.j) * 2 + dir) * 8 + h) * 16384;
                fu = P.useg + (size_t)seq * 7 * 16384; fd = P.dseg + seq * 7 * 128; sfin = nullptr;
            } else {
                const int q = it - 256, b = q >> 3; h = q & 7;
                rowbase = b * 256; T = 256; il0 = 0; nfold = 0; s0 = nullptr; fu = nullptr; fd = nullptr; sfin = P.s_out + ((size_t)((b * 2 + P.j) * 2 + dir) * 8 + h) * 16384;
            }
            const int itn = dir == 0 ? it : (it + F.G < 512 ? it + F.G : it), dirn = dir == 0 ? 1 : (it + F.G < 512 ? 0 : 1);
            const ScanCItem cn = scan_c_item(itn, dirn);
            const ScanNext NX{cn.rowbase, cn.T, cn.il0, cn.h, dirn};
            scan_item<false>(F, P, RA, RB, NX, rowbase, T, il0, 8, h, dir, s0, nfold, fu, fd, sfin, nullptr);
        }
    }
}
__device__ __forceinline__ void combine_phase(Frame& F, const bf16_t* OF, const bf16_t* OB, bf16_t* A2, const float* gn) {
    const int gw = F.bid * NWAVES + F.wave, NGW = F.G * NWAVES;
    const int ch = 16 * F.lane;
    float gv[16];
#pragma unroll
    for (int e = 0; e < 16; e += 4) { const f32x4 t = *(const f32x4*)(gn + ch + e); gv[e] = t[0]; gv[e + 1] = t[1]; gv[e + 2] = t[2]; gv[e + 3] = t[3]; }
    for (int row = gw; row < M_TOT; row += NGW) {
        const size_t o = (size_t)row * DM + ch;
        const u32x4 f0 = *(const u32x4*)(OF + o), f1 = *(const u32x4*)(OF + o + 8), b0 = *(const u32x4*)(OB + o), b1 = *(const u32x4*)(OB + o + 8);
        const u32x4 s0 = *(const u32x4*)(A2 + o), s1 = *(const u32x4*)(A2 + o + 8);
        float v[16]; float sq = 0.f;
#pragma unroll
        for (int e = 0; e < 4; ++e) { v[2 * e] = bf_lo(f0[e]) + bf_lo(b0[e]); v[2 * e + 1] = bf_hi(f0[e]) + bf_hi(b0[e]); v[8 + 2 * e] = bf_lo(f1[e]) + bf_lo(b1[e]); v[8 + 2 * e + 1] = bf_hi(f1[e]) + bf_hi(b1[e]); }
#pragma unroll
        for (int e = 0; e < 16; ++e) sq += v[e] * v[e];
        sq += __shfl_xor(sq, 1); sq += __shfl_xor(sq, 2); sq += __shfl_xor(sq, 4);
        const float rs = rsqrtf(sq * (1.f / 128.f) + EPS);
        u32x4 w0, w1;
#pragma unroll
        for (int e = 0; e < 4; ++e) {
            w0[e] = pk_bf16(v[2 * e] * rs * gv[2 * e] * bf_lo(s0[e]), v[2 * e + 1] * rs * gv[2 * e + 1] * bf_hi(s0[e]));
            w1[e] = pk_bf16(v[8 + 2 * e] * rs * gv[8 + 2 * e] * bf_lo(s1[e]), v[8 + 2 * e + 1] * rs * gv[8 + 2 * e + 1] * bf_hi(s1[e]));
        }
        *(u32x4*)(A2 + o) = w0; *(u32x4*)(A2 + o + 8) = w1;
    }
}

constexpr int AT_K = 0, AT_KSZ = 32 * 272, AT_V = 2 * AT_KSZ, AT_VSZ = 128 * 72, AT_END = AT_V + 2 * AT_VSZ;
static_assert(AT_END <= 131072, "attn lds");
struct AttnP { const bf16_t* Qa; const bf16_t* Ka; const bf16_t* VaT; const bf16_t* CK; const bf16_t* CVT; bf16_t* O; const float* sink; int j; };
__device__ __forceinline__ int crow(int r, int hi) { return (r & 3) + 8 * (r >> 2) + 4 * hi; }

__device__ __forceinline__ void attn_unit(Frame& F, const AttnP& P, int qrow0, int head0, const float* sinkp,
                                          const bf16_t* K0, int kst0, const bf16_t* V0, int vst0, int n0,
                                          const bf16_t* K1, int kst1, const bf16_t* V1, int vst1, int n1, int tok0_1, int tq0) {
    const lptr L = F.lds; const int tid = F.tid, lane = F.lane, w = F.wave, r32 = lane & 31, hi = lane >> 5;
    const int head = head0 + (w & 3), wq = w >> 2;
    const float sink_t = sinkp[head] * LOG2E;
    bf16x8 qf[8];
    { const bf16_t* qp = P.Qa + (size_t)(qrow0 + 32 * wq + r32) * DM + head * 128 + 8 * hi;
#pragma unroll
      for (int ks = 0; ks < 8; ++ks) qf[ks] = *(const bf16x8*)(qp + 16 * ks); }
    f32x16 o[4];
#pragma unroll
    for (int d = 0; d < 4; ++d)
#pragma unroll
        for (int r = 0; r < 16; ++r) o[d][r] = 0.f;
    float mrun = sink_t, lrun = hi == 0 ? 1.f : 0.f;
    const int ntile = (n0 + n1) >> 5, nt0 = n0 >> 5;
    const int tq = tq0 + 32 * wq + r32;
    const int skey = tid >> 4, sch = tid & 15, sd = tid >> 2, svc = tid & 3;
    u32x4 kreg, vreg;
#define AT_LOAD(t) do { int t_ = (t); t_ = t_ < ntile ? t_ : ntile - 1; const bool s1_ = t_ >= nt0; const int u_ = s1_ ? t_ - nt0 : t_; \
        const bf16_t* kp_ = (s1_ ? K1 : K0) + (size_t)(32 * u_ + skey) * (s1_ ? kst1 : kst0) + 8 * sch; const bf16_t* vp_ = (s1_ ? V1 : V0) + (size_t)sd * (s1_ ? vst1 : vst0) + 32 * u_ + 8 * svc; \
        kreg = *(const u32x4*)kp_; vreg = *(const u32x4*)vp_; } while (0)
#define AT_STORE(buf) do { *(LAS u32x4*)(L + AT_K + (buf) * AT_KSZ + skey * 272 + 16 * sch) = kreg; \
        *(LAS u32x2*)(L + AT_V + (buf) * AT_VSZ + sd * 72 + 16 * svc) = (u32x2){vreg.x, vreg.y}; *(LAS u32x2*)(L + AT_V + (buf) * AT_VSZ + sd * 72 + 16 * svc + 8) = (u32x2){vreg.z, vreg.w}; } while (0)
    AT_LOAD(0); AT_STORE(0);
    AT_LOAD(1);
    __syncthreads();
    for (int t = 0; t < ntile; ++t) {
        const int buf = t & 1;
        AT_STORE(buf ^ 1); AT_LOAD(t + 2);
        bool active = true; int kt0 = 0;
        if (t >= nt0) { kt0 = tok0_1 + 32 * (t - nt0); const int tw = tq0 + 32 * wq; active = (kt0 + 31 >= tw - 128) && (kt0 <= tw + 31 + 128); }
        if (active) {
            f32x16 s;
#pragma unroll
            for (int r = 0; r < 16; ++r) s[r] = 0.f;
            const lptr kb = L + AT_K + buf * AT_KSZ + r32 * 272 + 16 * hi;
            {
                bf16x8 kf[8];
#pragma unroll
                for (int ks = 0; ks < 8; ++ks) kf[ks] = *(const LAS bf16x8*)(kb + 32 * ks);
                __builtin_amdgcn_sched_barrier(0);
#pragma unroll
                for (int ks = 0; ks < 8; ++ks) s = __builtin_amdgcn_mfma_f32_32x32x16_bf16(kf[ks], qf[ks], s, 0, 0, 0);
            }
            if (t >= nt0) {
#pragma unroll
                for (int r = 0; r < 16; ++r) { const int dk = kt0 + crow(r, hi) - tq; if (dk > 128 || dk < -128) s[r] = -INFINITY; }
            }
            float tm = s[0];
#pragma unroll
            for (int r = 1; r < 16; ++r) tm = fmaxf(tm, s[r]);
            tm = fmaxf(tm, __shfl_xor(tm, 32));
            const float mn = fmaxf(mrun, tm), alpha = fast_exp2(mrun - mn);
            mrun = mn;
            float ps = 0.f;
#pragma unroll
            for (int r = 0; r < 16; ++r) { s[r] = fast_exp2(s[r] - mn); ps += s[r]; }
            lrun = lrun * alpha + ps;
#pragma unroll
            for (int d = 0; d < 4; ++d)
#pragma unroll
                for (int r = 0; r < 16; ++r) o[d][r] *= alpha;
            bf16x8 pf[2];
#pragma unroll
            for (int kk = 0; kk < 2; ++kk) { u32x4 pw; pw.x = pk_bf16(s[8 * kk + 0], s[8 * kk + 1]); pw.y = pk_bf16(s[8 * kk + 2], s[8 * kk + 3]); pw.z = pk_bf16(s[8 * kk + 4], s[8 * kk + 5]); pw.w = pk_bf16(s[8 * kk + 6], s[8 * kk + 7]); pf[kk] = __builtin_bit_cast(bf16x8, pw); }
            const lptr vbp = L + AT_V + buf * AT_VSZ + r32 * 72 + 8 * hi;
            {
                u32x4 vf[4][2];
#pragma unroll
                for (int d = 0; d < 4; ++d)
#pragma unroll
                    for (int kk = 0; kk < 2; ++kk) { const u32x2 lo = *(const LAS u32x2*)(vbp + d * 32 * 72 + 32 * kk), hh = *(const LAS u32x2*)(vbp + d * 32 * 72 + 32 * kk + 16); vf[d][kk] = (u32x4){lo.x, lo.y, hh.x, hh.y}; }
                __builtin_amdgcn_sched_barrier(0);
#pragma unroll
                for (int kk = 0; kk < 2; ++kk)
#pragma unroll
                    for (int d = 0; d < 4; ++d) o[d] = __builtin_amdgcn_mfma_f32_32x32x16_bf16(__builtin_bit_cast(bf16x8, vf[d][kk]), pf[kk], o[d], 0, 0, 0);
            }
        }
        __syncthreads();
    }
#undef AT_LOAD
#undef AT_STORE
    const float lt = lrun + __shfl_xor(lrun, 32);
    const float inv = fast_rcp(lt);
    bf16_t* op = P.O + (size_t)(qrow0 + 32 * wq + r32) * DM + head * 128 + 8 * hi;
#pragma unroll
    for (int d = 0; d < 4; ++d)
#pragma unroll
        for (int u = 0; u < 4; u += 2) {
            const unsigned vx = pk_bf16(o[d][4 * u] * inv, o[d][4 * u + 1] * inv), vy = pk_bf16(o[d][4 * u + 2] * inv, o[d][4 * u + 3] * inv);
            const unsigned wx = pk_bf16(o[d][4 * u + 4] * inv, o[d][4 * u + 5] * inv), wy = pk_bf16(o[d][4 * u + 6] * inv, o[d][4 * u + 7] * inv);
            const auto r0 = __builtin_amdgcn_permlane32_swap(vx, wx, false, false), r1 = __builtin_amdgcn_permlane32_swap(vy, wy, false, false);
            *(u32x4*)(op + 32 * d + 8 * u) = (u32x4){r0[0], r1[0], r0[1], r1[1]};
        }
}
__device__ __forceinline__ void attn_phase(Frame& F, const AttnP& P) {
    for (int u = F.bid; u < 256; u += F.G) {
        { const int b = u >> 3, kvh = (u >> 2) & 1, qb = u & 3;
          attn_unit(F, P, b * 256 + qb * 64, kvh * 4, P.sink + P.j * 8,
                    P.Ka + (size_t)(b * 256) * 256 + kvh * 128, 256, P.VaT + (size_t)(b * 2 + kvh) * 128 * 256, 256, 256,
                    nullptr, 0, nullptr, 0, 0, 0, 0); }
        { const int b = u >> 6, kvh = (u >> 5) & 1, qb = u & 31;
          const int lo = qb * 64 - 128 < 0 ? 0 : qb * 64 - 128, hi = qb * 64 + 192 > 2048 ? 2048 : qb * 64 + 192;
          attn_unit(F, P, M_CTX + b * 2048 + qb * 64, kvh * 4, P.sink + P.j * 8,
                    P.CK + ((size_t)(b * 2 + P.j) * 512) * 256 + kvh * 128, 256, P.CVT + (size_t)((b * 2 + P.j) * 2 + kvh) * 128 * 512, 512, 512,
                    P.Ka + (size_t)(M_CTX + b * 2048 + lo) * 256 + kvh * 128, 256, P.VaT + (size_t)2097152 + (size_t)(b * 2 + kvh) * 128 * 2048 + lo, 2048, hi - lo, lo, qb * 64); }
    }
}

__device__ __forceinline__ void final_phase(Frame& F) {
    const int gw = F.bid * NWAVES + F.wave, NGW = F.G * NWAVES;
    const unsigned* ss = (const unsigned*)(F.ws + WS_SS) + (size_t)8 * M_TOT;
    const f32x4 nf[4] = {*(const f32x4*)(F.in[11] + 4 * F.lane), *(const f32x4*)(F.in[11] + 4 * F.lane + 256), *(const f32x4*)(F.in[11] + 4 * F.lane + 512), *(const f32x4*)(F.in[11] + 4 * F.lane + 768)};
    for (int row0 = 4 * gw; row0 < M_TOT; row0 += 4 * NGW) {
        u32x2 xw[4][4]; float rstd[4];
#pragma unroll
        for (int q = 0; q < 4; ++q) { rstd[q] = ss_rstd(ss, row0 + q); const bf16_t* xr = (const bf16_t*)(F.ws + WS_XB) + (size_t)(row0 + q) * DM;
#pragma unroll
            for (int jx = 0; jx < 4; ++jx) xw[q][jx] = *(const u32x2*)(xr + 4 * F.lane + 256 * jx); }
        asm volatile("" ::: "memory");
#pragma unroll
        for (int q = 0; q < 4; ++q) { float* yr = F.out + (size_t)(row0 + q) * DM;
#pragma unroll
            for (int jx = 0; jx < 4; ++jx) { const u32x2 t = xw[q][jx]; const f32x4 v = {bf_lo(t.x), bf_hi(t.x), bf_lo(t.y), bf_hi(t.y)}; *(f32x4*)(yr + 4 * F.lane + 256 * jx) = v * rstd[q] * nf[jx]; } }
    }
}

constexpr int LDS_BYTES = 163840, MISC_OFF = 163840 - 256;
constexpr int NPHASE = 25;
#ifndef KMASK
#define KMASK 0x7ff
#endif
#define KON(k) (((KMASK) >> (k)) & 1)
#ifndef PROBE_MASK
#define PROBE_MASK 0u
#endif
#ifndef PROBE_MULT
#define PROBE_MULT 8
#endif

template <int PH>
__device__ __forceinline__ void run_phase(Frame& F) {
    { size_t z0 = 0, z1 = 0; asm volatile("" : "+s"(z0), "+s"(z1)); F.ws = F.ws0 + z0; F.out = F.out0 + z1; asm volatile("" : "+s"(F.in.p)); }
    asm volatile("" : "+s"(F.wave));
    F.lane = __builtin_amdgcn_mbcnt_hi(~0u, __builtin_amdgcn_mbcnt_lo(~0u, 0u)); asm volatile("" : "+v"(F.lane)); F.tid = F.wave * 64 + F.lane;
    unsigned char* ws = F.ws;
    if constexpr (PH == 0) { if (KON(0)) phase0a(F); }
    else if constexpr (PH == 1) { if (KON(1)) phase0b(F); }
    else if constexpr (PH == NPHASE - 1) { if (KON(2)) final_phase(F); }
    else {
        constexpr int p = PH - 2;
        constexpr int l = p < 6 ? 0 : (p < 11 ? 1 : (p < 17 ? 2 : 3));
        constexpr int sub = p < 6 ? p : (p < 11 ? p - 6 : (p < 17 ? p - 11 : p - 17));
        constexpr bool hg = (l & 1) == 0; constexpr int j = l >> 1;
        constexpr int s_mix = hg ? 3 : 2, s_gu = s_mix + 1, s_dn = s_mix + 2;
        pg8::StaticOrder S;
        if constexpr (sub == 0 && hg) { if (KON(3)) {
            pg8::Gemm g{(const bf16_t*)(ws + WS_XA), (const bf16_t*)(ws + WS_W_IN) + (size_t)j * A_IN * DM, M_TOT, A_IN, DM}; S.init(M_TOT, A_IN, F.G, F.bid);
            EpiIn E{ws, l};
            pg8::gemm_phase(F.lds, F.tid, g, S, E);
        } } else if constexpr ((sub == 1 || sub == 2) && hg) { if (KON(4)) {
            ScanP P{(const bf16_t*)(ws + WS_HQ), (const bf16_t*)(ws + WS_HV), (bf16_t*)(ws + WS_HKF), (bf16_t*)(ws + WS_HKB), (const unsigned short*)(ws + WS_HGF), (const unsigned short*)(ws + WS_HGB),
                    F.in[4], F.out + OUT_ST, (float*)(ws + WS_XA), (float*)(ws + WS_XA) + (size_t)448 * 16384, j, (bf16_t*)(ws + WS_OFW), (bf16_t*)(ws + WS_A2), F.in[16] + (size_t)j * DM};
            if constexpr (sub == 1) scan_phase_a(F, P); else scan_phase_c(F, P);
        } } else if constexpr (sub == 0 && !hg) { if (KON(6)) {
            pg8::Gemm g{(const bf16_t*)(ws + WS_XA), (const bf16_t*)(ws + WS_W_QKV) + (size_t)j * QKV_N * DM, M_TOT, QKV_N, DM}; S.init(M_TOT, QKV_N, F.G, F.bid);
            EpiQkv E{ws, F.out, l};
            if constexpr (l == 3) { pg8::HalfTailOrder SH; SH.init(M_TOT, QKV_N, F.G, F.bid); pg8::gemm_phase<EpiQkv, pg8::HalfTailOrder, true>(F.lds, F.tid, g, SH, E); }
            else pg8::gemm_phase(F.lds, F.tid, g, S, E);
            if constexpr (l == 1) { if (F.bid >= 128) { __syncthreads(); adaln_layer<8>(F, 2, F.bid - 128, F.G - 128); convert_set(F, 2, (F.bid - 128) * NWAVES + F.wave, (F.G - 128) * NWAVES); } }
        } } else if constexpr (sub == 1 && !hg) { if (KON(7)) {
            AttnP P{(const bf16_t*)(ws + WS_AQ), (const bf16_t*)(ws + WS_AK), (const bf16_t*)(ws + WS_AVT), (const bf16_t*)(ws + WS_CK), (const bf16_t*)(ws + WS_CVT), (bf16_t*)(ws + WS_A2), F.in[20], j};
            attn_phase(F, P);
        } } else if constexpr (sub == s_mix) { if (KON(8)) {
            const bf16_t* wt = hg ? (const bf16_t*)(ws + WS_W_OUTA) + (size_t)j * DM * DM : (const bf16_t*)(ws + WS_W_OUTB) + (size_t)j * DM * DM;
            pg8::Gemm g{(const bf16_t*)(ws + WS_A2), wt, M_TOT, DM, DM}; S.init(M_TOT, DM, F.G, F.bid);
            EpiRes E{ws, F.out, F.in, l, 0, F.lds};
            pg8::gemm_phase(F.lds, F.tid, g, S, E);
        } } else if constexpr (sub == s_gu) { if (KON(9)) {
            pg8::Gemm g{(const bf16_t*)(ws + WS_XA), (const bf16_t*)(ws + WS_W_GU) + (size_t)l * GU_N * DM, M_TOT, GU_N, DM}; S.init(M_TOT, GU_N, F.G, F.bid);
            EpiGU E{ws, l};
            if constexpr (l == 3) { pg8::HalfTailOrder SH; SH.init(M_TOT, GU_N, F.G, F.bid); pg8::gemm_phase<EpiGU, pg8::HalfTailOrder, true>(F.lds, F.tid, g, SH, E); }
            else pg8::gemm_phase(F.lds, F.tid, g, S, E);
            if constexpr (l < 3) { if (F.bid >= 128) { __syncthreads(); if constexpr (l != 1) adaln_layer<8>(F, l + 1, F.bid - 128, F.G - 128); convert_set(F, l == 0 ? 1 : (l == 1 ? 3 : 4), (F.bid - 128) * NWAVES + F.wave, (F.G - 128) * NWAVES); } }
        } } else if constexpr (sub == s_dn) { if (KON(10)) {
            pg8::Gemm g{(const bf16_t*)(ws + WS_H), (const bf16_t*)(ws + WS_W_DN) + (size_t)l * DM * D_FF, M_TOT, DM, D_FF}; S.init(M_TOT, DM, F.G, F.bid);
            EpiRes E{ws, F.out, F.in, l, 1, F.lds};
            pg8::gemm_phase(F.lds, F.tid, g, S, E);
            if constexpr (l < 3) bias_layer(F, l + 1, F.bid * NWAVES + F.wave, F.G * NWAVES);
        } }
    }
}

__global__ void __launch_bounds__(NTHREADS, 2) mk_fwd(Args args) {
    extern __shared__ __attribute__((aligned(16))) unsigned char lds_raw[];
    Frame F; F.lds = (lptr)lds_raw; F.tid = threadIdx.x; F.lane = F.tid & 63; F.wave = __builtin_amdgcn_readfirstlane(F.tid >> 6); F.G = gridDim.x; F.bid = blockIdx.x;
    F.in.p = (__attribute__((address_space(4))) const cfp_t*)__builtin_amdgcn_kernarg_segment_ptr(); F.out = args.out; F.ws = args.ws; F.out0 = args.out; F.ws0 = args.ws;
    volatile LAS unsigned* MISC = (volatile LAS unsigned*)(F.lds + MISC_OFF);
    if (F.tid < 32) MISC[F.tid] = 0u;
    __syncthreads();
    XcdBarrier bar = xcd_barrier_post((unsigned*)(F.ws + WS_CTL) + 4096, MISC + 8);
    const int lo = args.ph_lo, hi = args.ph_hi;
    unsigned long long pt_prev = 0ull, pt_acc = 0ull;
    if (PROBE_MASK) pt_prev = __builtin_amdgcn_s_memrealtime();
#define RUN(PH) if (lo <= (PH) && (PH) < hi) { run_phase<PH>(F); \
        if ((PH) + 1 < hi) { { bar.bar = (unsigned*)(F.ws0 + WS_CTL) + 4096; xcd_barrier(bar); } } \
        if (PROBE_MASK) { const unsigned long long t_ = __builtin_amdgcn_s_memrealtime(); if ((PROBE_MASK >> (PH)) & 1u) pt_acc += t_ - pt_prev; pt_prev = t_; } }
    RUN(0) RUN(1) RUN(2) RUN(3) RUN(4) RUN(5) RUN(6) RUN(7) RUN(8) RUN(9) RUN(10) RUN(11) RUN(12)
    RUN(13) RUN(14) RUN(15) RUN(16) RUN(17) RUN(18) RUN(19) RUN(20) RUN(21) RUN(22) RUN(23) RUN(24)
#undef RUN
    if (PROBE_MASK) { if (blockIdx.x == 0) { const unsigned long long t0 = __builtin_amdgcn_s_memrealtime(); while (__builtin_amdgcn_s_memrealtime() - t0 < (unsigned long long)PROBE_MULT * pt_acc) __builtin_amdgcn_s_sleep(8); } }
}

extern "C" void kernel_launch(void* const* d_in, const int* in_sizes, int n_in, void* d_out, int out_size, void* d_ws, size_t ws_size, hipStream_t stream) {
    static int grid = 0;
    if (grid == 0) {
        if (n_in != 21 || out_size != (int)OUT_TOTAL || ws_size < WS_END) { fprintf(stderr, "kernel_launch: unexpected shapes: n_in %d out %d ws %zu (need %zu)\n", n_in, out_size, ws_size, (size_t)WS_END); grid = -1; return; }
        int dev = 0, cus = 0, per_cu = 0;
        if (hipGetDevice(&dev) != hipSuccess || hipDeviceGetAttribute(&cus, hipDeviceAttributeMultiprocessorCount, dev) != hipSuccess) { grid = -1; return; }
        if (hipFuncSetAttribute((const void*)mk_fwd, hipFuncAttributeMaxDynamicSharedMemorySize, LDS_BYTES) != hipSuccess) { fprintf(stderr, "kernel_launch: hipFuncSetAttribute failed\n"); grid = -1; return; }
        if (hipOccupancyMaxActiveBlocksPerMultiprocessor(&per_cu, (const void*)mk_fwd, NTHREADS, LDS_BYTES) != hipSuccess || per_cu < 1) { fprintf(stderr, "kernel_launch: occupancy query %d\n", per_cu); (void)hipGetLastError(); grid = -1; return; }
        grid = cus;
    }
    if (grid < 0) return;
    if (hipMemsetAsync((char*)d_ws + WS_CTL, 0, WS_ZERO_BYTES, stream) != hipSuccess) return;
    Args a{};
    for (int i = 0; i < 21; ++i) a.in[i] = (const float*)d_in[i];
    a.out = (float*)d_out; a.ws = (unsigned char*)d_ws; a.ph_lo = 0; a.ph_hi = NPHASE;
    void* args[] = {&a};
    hipError_t e = hipLaunchCooperativeKernel((const void*)mk_fwd, dim3(grid), dim3(NTHREADS), args, LDS_BYTES, stream);
    if (e != hipSuccess) fprintf(stderr, "cooperative launch failed: %s (grid %d)\n", hipGetErrorString(e), grid);
}
```
